# Optimizing an MI355X kernel written in HIP

```python
import math
import jax, jax.numpy as jnp
from jax import lax
import numpy as np

D_MODEL = 1024
BATCH = 16
SEQ = 2048
DEPTH = 1

HEAD_DIM = 64
D_MIX = D_MODEL
N_HEADS_A = 8
N_HEADS_B = 8
WIDTH_A = N_HEADS_A * HEAD_DIM
WIDTH_B = N_HEADS_B * HEAD_DIM
ROT_DIM = HEAD_DIM // 4
ROPE_THETA = 500000.0
DILATED_PATTERNS = ((128, 1), (512, 4), (2048, 16))
WIN_BLOCK = 128
KV_LATENT = 128
IDX_HEADS = 4
IDX_DIM = 64
TOPK_MAX = 256
Q_BLOCK = 128
EPS = 1e-6
IN_SPLITS = (WIDTH_A, WIDTH_A, WIDTH_A, WIDTH_A,
             WIDTH_B, KV_LATENT, WIDTH_B,
             IDX_HEADS * IDX_DIM, IDX_DIM, IDX_HEADS)
D_IN = sum(IN_SPLITS)

kernel_name = "hybrid_dilated_window_dsa_parallel_heads"


def rmsnorm(x, g):
    xf = x.astype(jnp.float32)
    y = xf * lax.rsqrt(jnp.mean(xf * xf, axis=-1, keepdims=True) + EPS)
    return (y * g.astype(jnp.float32)).astype(x.dtype)


def rope_tables(positions):
    inv_freq = ROPE_THETA ** (-jnp.arange(0, ROT_DIM, 2, dtype=jnp.float32) / ROT_DIM)
    ang = positions.astype(jnp.float32)[..., None] * inv_freq
    return jnp.cos(ang), jnp.sin(ang)


def apply_rope(x, cos, sin):
    half = ROT_DIM // 2
    xr = x[..., :ROT_DIM].astype(jnp.float32)
    x1, x2 = xr[..., :half], xr[..., half:]
    rot = jnp.concatenate([x1 * cos - x2 * sin, x2 * cos + x1 * sin], axis=-1)
    return jnp.concatenate([rot.astype(x.dtype), x[..., ROT_DIM:]], axis=-1)


def split_columns(proj):
    offs = [int(v) for v in np.cumsum(IN_SPLITS)[:-1]]
    return jnp.split(proj, offs, axis=-1)


def dilated_window_pattern(q, k, v, dilation, steps):
    B, S, H, D = q.shape
    n = S // dilation
    nb = -(-n // WIN_BLOCK)
    npad = nb * WIN_BLOCK

    def to_sub(t):
        t = t.reshape(B, n, dilation, H, D)
        return jnp.pad(t, ((0, 0), (0, npad - n), (0, 0), (0, 0), (0, 0)))

    def band(t):
        tp = jnp.pad(t, ((0, 0), (WIN_BLOCK, 0), (0, 0), (0, 0), (0, 0)))
        tp = tp.reshape(B, nb + 1, WIN_BLOCK, dilation, H, D)
        return jnp.concatenate([tp[:, :-1], tp[:, 1:]], axis=2)

    qb = to_sub(q).reshape(B, nb, WIN_BLOCK, dilation, H, D)
    kb = band(to_sub(k))
    vb = band(to_sub(v))
    s = jnp.einsum('bnqrhd,bnkrhd->bnrhqk', qb, kb).astype(jnp.float32) * (D ** -0.5)
    qi = jnp.arange(WIN_BLOCK)[:, None]
    kj = jnp.arange(2 * WIN_BLOCK)[None, :]
    diff = qi + WIN_BLOCK - kj
    key_step = jnp.arange(nb)[:, None, None] * WIN_BLOCK - WIN_BLOCK + kj[None]
    mask = (diff >= 0) & (diff <= steps) & (key_step >= 0)
    s = jnp.where(mask[None, :, None, None], s, -jnp.inf)
    m = jnp.max(s, axis=-1, keepdims=True)
    p = jnp.exp(s - m)
    l = jnp.sum(p, axis=-1, keepdims=True)
    o = jnp.einsum('bnrhqk,bnkrhd->bnqrhd', (p / l).astype(v.dtype), vb)
    lse = (m + jnp.log(l))[..., 0]
    o = o.reshape(B, npad, dilation, H, D)[:, :n].reshape(B, S, H, D)
    lse = lse.transpose(0, 1, 4, 2, 3).reshape(B, npad, dilation, H)[:, :n].reshape(B, S, H)
    return o, lse


def dilated_mixture(q, k, v):
    outs, lses = [], []
    for window, dilation in DILATED_PATTERNS:
        o, lse = dilated_window_pattern(q, k, v, dilation, window // dilation)
        outs.append(o)
        lses.append(lse)
    alpha = jax.nn.softmax(jnp.stack(lses, axis=-1), axis=-1)
    o = jnp.stack(outs, axis=-1).astype(jnp.float32)
    return jnp.einsum('bshdp,bshp->bshd', o, alpha).astype(q.dtype)


def indexed_sparse_attention(q, k, latent, iq, ik, iw):
    B, S, HB, D = q.shape
    n_blocks = S // Q_BLOCK
    topk = min(TOPK_MAX, S // 4)
    b_idx = jnp.arange(B)[:, None, None]
    key_pos = jnp.arange(S)

    def to_blocks(t):
        return jnp.swapaxes(t.reshape((B, n_blocks, Q_BLOCK) + t.shape[2:]), 0, 1)

    def block_fn(args):
        qb, iqb, iwb, start = args
        t = start + jnp.arange(Q_BLOCK)
        sc_idx = jnp.einsum('bqhd,bsd->bqhs', iqb, ik).astype(jnp.float32)
        index_score = jnp.einsum('bqhs,bqh->bqs', jax.nn.relu(sc_idx), iwb.astype(jnp.float32))
        admissible = key_pos[None, None, :] <= t[None, :, None]
        index_score = jnp.where(admissible, index_score, -jnp.inf)
        _, sel = lax.top_k(index_score, topk)
        valid = sel <= t[None, :, None]
        k_sel = k[b_idx, sel]
        v_sel = latent[b_idx, sel]
        s = jnp.einsum('bqhd,bqkd->bqhk', qb, k_sel).astype(jnp.float32) * (D ** -0.5)
        s = jnp.where(valid[:, :, None, :], s, -jnp.inf)
        p = jax.nn.softmax(s, axis=-1).astype(v_sel.dtype)
        return jnp.einsum('bqhk,bqkc->bqhc', p, v_sel)

    starts = jnp.arange(n_blocks, dtype=jnp.int32) * Q_BLOCK
    out = lax.map(block_fn, (to_blocks(q), to_blocks(iq), to_blocks(iw), starts))
    return jnp.swapaxes(out, 0, 1).reshape(B, S, HB, latent.shape[-1])


def setup_inputs(seed: int = 0) -> dict:
    key = jax.random.key(seed)
    ks = jax.random.split(key, 12)
    x = jax.random.normal(ks[0], (BATCH, SEQ, D_MODEL), jnp.float32)
    start = jax.random.randint(ks[1], (BATCH, 1), 0, 4096, dtype=jnp.int32)
    positions = (start + jnp.arange(SEQ, dtype=jnp.int32)[None, :]).astype(jnp.int32)

    def gain(k, n):
        return 1.0 + 0.01 * jax.random.normal(k, (DEPTH, n), jnp.float32)

    return {
        "x": x,
        "positions": positions,
        "norm_in_gain": gain(ks[2], D_MODEL),
        "w_in": jax.random.normal(ks[3], (DEPTH, D_MODEL, D_IN), jnp.float32) * D_MODEL ** -0.5,
        "kv_norm_gain": gain(ks[4], KV_LATENT),
        "w_uk": jax.random.normal(ks[5], (DEPTH, KV_LATENT, HEAD_DIM), jnp.float32) * KV_LATENT ** -0.5,
        "w_uv": jax.random.normal(ks[6], (DEPTH, N_HEADS_B, KV_LATENT, HEAD_DIM), jnp.float32) * KV_LATENT ** -0.5,
        "idx_k_norm_gain": gain(ks[7], IDX_DIM),
        "branch_norm_gain_a": gain(ks[8], WIDTH_A),
        "branch_norm_gain_b": gain(ks[9], WIDTH_B),
        "w_out": jax.random.normal(ks[10], (DEPTH, D_MIX, D_MODEL), jnp.float32) * D_MIX ** -0.5,
        "final_norm_gain": 1.0 + 0.01 * jax.random.normal(ks[11], (D_MODEL,), jnp.float32),
    }


def reference(x, positions, norm_in_gain, w_in, kv_norm_gain, w_uk, w_uv, idx_k_norm_gain,
              branch_norm_gain_a, branch_norm_gain_b, w_out, final_norm_gain):
    B, S, _ = x.shape
    cos, sin = rope_tables(positions)
    cos_h, sin_h = cos[:, :, None, :], sin[:, :, None, :]
    h = x
    for layer in range(DEPTH):
        u = rmsnorm(h, norm_in_gain[layer])
        proj = u @ w_in[layer]
        qa, ka, va, za, qb, ckv, zb, iq, ik, iw = split_columns(proj)

        qa = apply_rope(qa.reshape(B, S, N_HEADS_A, HEAD_DIM), cos_h, sin_h)
        ka = apply_rope(ka.reshape(B, S, N_HEADS_A, HEAD_DIM), cos_h, sin_h)
        va = va.reshape(B, S, N_HEADS_A, HEAD_DIM)
        o_a = dilated_mixture(qa, ka, va).reshape(B, S, WIDTH_A)
        y_a = rmsnorm(o_a * jax.nn.silu(za), branch_norm_gain_a[layer])

        qb = apply_rope(qb.reshape(B, S, N_HEADS_B, HEAD_DIM), cos_h, sin_h)
        ckv = rmsnorm(ckv, kv_norm_gain[layer])
        kb = apply_rope(ckv @ w_uk[layer], cos, sin)
        iq = apply_rope(iq.reshape(B, S, IDX_HEADS, IDX_DIM), cos_h, sin_h)
        ik = apply_rope(rmsnorm(ik, idx_k_norm_gain[layer]), cos, sin)
        iw = iw * (IDX_HEADS ** -0.5 * IDX_DIM ** -0.5)
        o_lat = indexed_sparse_attention(qb, kb, ckv, iq, ik, iw)
        o_b = jnp.einsum('bshc,hcd->bshd', o_lat, w_uv[layer]).reshape(B, S, WIDTH_B)
        y_b = rmsnorm(o_b * jax.nn.silu(zb), branch_norm_gain_b[layer])

        h = h + jnp.concatenate([y_a, y_b], axis=-1) @ w_out[layer]
    return rmsnorm(h, final_norm_gain)
```

```cpp
#include <hip/hip_runtime.h>
#include <cstdio>
#include <cstdint>
namespace pg8 {
#define PG8_LAS __attribute__((address_space(3)))
typedef unsigned short bf16_t;
typedef short bf16x8 __attribute__((ext_vector_type(8)));
typedef float f32x4 __attribute__((ext_vector_type(4)));
typedef unsigned u32x4 __attribute__((ext_vector_type(4)));
constexpr int BM = 256, BK = 64, HALF = 128, HTB = HALF * BK * 2  , STAGE_BYTES = 8 * HTB, NXCD = 8, WGM = 8;

__host__ __device__ __forceinline__ int lds_byte(int r, int c) { const int st = (r >> 4) * 2 + (c >> 5), rr = r & 15, cc = c & 31, ob = rr * 64 + cc * 2; return st * 1024 + (ob ^ (((ob >> 9) & 1) << 5)); }
__host__ __device__ __forceinline__ void stage_rc(int b, int& R, int& C) { const int st = b / 1024, sb = b % 1024, swz = sb ^ (((sb >> 9) & 1) << 5); R = (st >> 1) * 16 + swz / 64; C = (st & 1) * 32 + (swz % 64) / 2; }
__host__ __device__ __forceinline__ int perm32(int rho) { const int n = rho >> 4, i = rho & 15; return 8 * (i >> 2) + 4 * n + (i & 3); }

struct Unit { int pm, pn; };
struct Gemm { const bf16_t* A; const bf16_t* Bt; int M, N, K; };

struct StaticOrder {
    int nM, nN, nwg, G, c;
    __host__ __device__ void init(int M, int N, int G_, int c_) { nM = M / BM; nN = N / BM; nwg = nM * nN; G = G_; c = c_; }
    __host__ __device__ bool next(int i, Unit& u) const {
        const long L = (long)i * G + c; if (L >= nwg) return false;
        int wgid = (int)L; { const int q = nwg / NXCD, r = nwg % NXCD, xcd = wgid % NXCD, off = wgid / NXCD; wgid = (xcd < r ? xcd * (q + 1) : r * (q + 1) + (xcd - r) * q) + off; }
        const int nig = WGM * nN, gid = wgid / nig, fm = gid * WGM, gsz = (nM - fm) < WGM ? (nM - fm) : WGM;
        u.pm = fm + ((wgid % nig) % gsz); u.pn = (wgid % nig) / gsz; return true;
    }
    __device__ __forceinline__ void a_ready(const Unit&) const {}
    __device__ __forceinline__ void done(const Unit&) const {}
};

template <class Epi, class Sched, bool ALIGN_EPI = false, bool SP2 = false>
__device__ __forceinline__ void gemm_phase(PG8_LAS unsigned char* lds, const Gemm g, const Sched& S, const Epi& E) {
    const int tid = threadIdx.x, wid = __builtin_amdgcn_readfirstlane(tid >> 6), lane = tid & 63, wr = wid >> 2, wc = wid & 3, fr = lane & 15, fq = lane >> 4;
    const int K = g.K, nt = K / BK;
    unsigned voffA[2], voffB[2];
#pragma unroll
    for (int i = 0; i < 2; ++i) { int R, C; stage_rc(tid * 16 + i * 8192, R, C); const int Rb = Epi::PERM ? ((R & ~31) + perm32(R & 31)) : R;
        voffA[i] = (unsigned)(R * K + C) * 2u; voffB[i] = (unsigned)(Rb * K + C) * 2u; }
    const size_t kstep = (size_t)(BK * 2);
    const size_t hstep = (size_t)HALF * K * 2;
    const size_t tstep = 2 * hstep;
    const unsigned ldsw = (unsigned)wid * 1024u;
    const int aoff = lds_byte(wr * 64 + fr, fq * 8), boff = lds_byte(wc * 32 + fr, fq * 8);
#define PG8_SA(b, h) (((b) * 2 + (h)) * HTB)
#define PG8_SB(b, h) ((4 + (b) * 2 + (h)) * HTB)
#define PG8_STAGE(bufoff, gbase, voff) do { _Pragma("unroll") for (int _i = 0; _i < 2; ++_i) \
        __builtin_amdgcn_global_load_lds((const unsigned*)((const char*)(gbase) + (voff)[_i]), (PG8_LAS unsigned*)(lds + (bufoff) + ldsw + _i * 8192), 16, 0, 0); } while (0)
#define PG8_LDA(dst, b, h) do { _Pragma("unroll") for (int m = 0; m < 4; ++m) _Pragma("unroll") for (int k = 0; k < 2; ++k) dst[m][k] = *(const PG8_LAS bf16x8*)(lds + PG8_SA(b, h) + aoff + m * 2048 + k * 1024); } while (0)
#define PG8_LDB(dst, b, h) do { _Pragma("unroll") for (int n = 0; n < 2; ++n) _Pragma("unroll") for (int k = 0; k < 2; ++k) dst[n][k] = *(const PG8_LAS bf16x8*)(lds + PG8_SB(b, h) + boff + n * 2048 + k * 1024); } while (0)
#define PG8_MMA(ai, bj, At, Bt) do { __builtin_amdgcn_s_setprio(1); _Pragma("unroll") for (int m = 0; m < 4; ++m) _Pragma("unroll") for (int n = 0; n < 2; ++n) _Pragma("unroll") for (int k = 0; k < 2; ++k) \
        acc[ai][bj][m][n] = __builtin_amdgcn_mfma_f32_16x16x32_bf16(Bt[n][k], At[m][k], acc[ai][bj][m][n], 0, 0, 0); __builtin_amdgcn_s_setprio(0); } while (0)
#define PG8_WAIT_V(n) asm volatile("s_waitcnt vmcnt(" #n ")" ::: "memory")
#define PG8_WAIT_L(n) asm volatile("s_waitcnt lgkmcnt(" #n ")" ::: "memory")
#define PG8_BAR __builtin_amdgcn_s_barrier()
#define PG8_SCHED __builtin_amdgcn_sched_barrier(0)
    Unit cur, nxt; int ui = 0;
    if (!S.next(0, cur)) return;
    f32x4 acc[2][2][4][2];
#pragma unroll
    for (int a = 0; a < 2; ++a)
#pragma unroll
        for (int b = 0; b < 2; ++b)
#pragma unroll
            for (int m = 0; m < 4; ++m)
#pragma unroll
                for (int n = 0; n < 2; ++n) acc[a][b][m][n] = (f32x4){0.f, 0.f, 0.f, 0.f};
    bf16x8 At[4][2], B0[2][2], B1[2][2];
    const char* cA = (const char*)g.A + (size_t)cur.pm * tstep; const char* cB = (const char*)g.Bt + (size_t)cur.pn * tstep;
    S.a_ready(cur);
    if constexpr (SP2) {
        PG8_STAGE(PG8_SB(0, 0), cB, voffB); PG8_STAGE(PG8_SB(0, 1), cB + hstep, voffB); PG8_STAGE(PG8_SA(0, 0), cA, voffA); PG8_STAGE(PG8_SA(0, 1), cA + hstep, voffA);
        if (wr == 1) PG8_BAR;
        PG8_WAIT_V(2); PG8_BAR;
        PG8_STAGE(PG8_SB(1, 0), cB + kstep, voffB); PG8_STAGE(PG8_SA(1, 0), cA + kstep, voffA); PG8_STAGE(PG8_SB(1, 1), cB + hstep + kstep, voffB);
        PG8_WAIT_V(6); PG8_BAR;
    } else {
        PG8_STAGE(PG8_SB(0, 0), cB, voffB); PG8_STAGE(PG8_SA(0, 0), cA, voffA); PG8_STAGE(PG8_SB(0, 1), cB + hstep, voffB); PG8_STAGE(PG8_SA(0, 1), cA + hstep, voffA);
        if (wr == 1) PG8_BAR;
        PG8_WAIT_V(4); PG8_BAR;
        PG8_STAGE(PG8_SB(1, 0), cB + kstep, voffB); PG8_STAGE(PG8_SA(1, 0), cA + kstep, voffA); PG8_STAGE(PG8_SB(1, 1), cB + hstep + kstep, voffB);
        PG8_WAIT_V(6); PG8_BAR;
    }
    for (;;) {
        const bool has_next = S.next(ui + 1, nxt);
        const char* nA = has_next ? (const char*)g.A + (size_t)nxt.pm * tstep : cA; const char* nB = has_next ? (const char*)g.Bt + (size_t)nxt.pn * tstep : cB;
        for (int t = 0; t < nt; t += 2) {
            const bool last = (t == nt - 2);
            const char* a1 = cA + (size_t)(t + 1) * kstep;
            const char* a2 = last ? nA : cA + (size_t)(t + 2) * kstep; const char* b2 = last ? nB : cB + (size_t)(t + 2) * kstep;
            const char* a3 = a2 + kstep; const char* b3 = b2 + kstep;
            if (last && has_next) S.a_ready(nxt);
            if constexpr (SP2) {
            PG8_LDB(B0, 0, 0); PG8_LDB(B1, 0, 1); PG8_SCHED; PG8_LDA(At, 0, 0); PG8_STAGE(PG8_SA(1, 1), a1 + hstep, voffA);
            PG8_WAIT_V(8); PG8_WAIT_L(0); PG8_BAR; PG8_MMA(0, 0, At, B0); PG8_MMA(0, 1, At, B1); PG8_BAR; PG8_SCHED;
            PG8_LDA(At, 0, 1); PG8_STAGE(PG8_SB(0, 0), b2, voffB); PG8_STAGE(PG8_SB(0, 1), b2 + hstep, voffB); PG8_STAGE(PG8_SA(0, 0), a2, voffA);
            PG8_WAIT_V(8); PG8_WAIT_L(0); PG8_BAR; PG8_MMA(1, 0, At, B0); PG8_MMA(1, 1, At, B1); PG8_BAR; PG8_SCHED;
            PG8_LDB(B0, 1, 0); PG8_LDB(B1, 1, 1); PG8_SCHED; PG8_LDA(At, 1, 0); PG8_STAGE(PG8_SA(0, 1), a2 + hstep, voffA);
            PG8_WAIT_V(8); PG8_WAIT_L(0); PG8_BAR; PG8_MMA(0, 0, At, B0); PG8_MMA(0, 1, At, B1); PG8_BAR; PG8_SCHED;
            PG8_LDA(At, 1, 1); PG8_STAGE(PG8_SB(1, 0), b3, voffB); PG8_STAGE(PG8_SB(1, 1), b3 + hstep, voffB); PG8_STAGE(PG8_SA(1, 0), a3, voffA);
            PG8_WAIT_V(8); PG8_WAIT_L(0); PG8_BAR; PG8_MMA(1, 0, At, B0); PG8_MMA(1, 1, At, B1); PG8_BAR; PG8_SCHED;
            } else {
            PG8_LDB(B0, 0, 0); PG8_SCHED; PG8_LDA(At, 0, 0); PG8_STAGE(PG8_SA(1, 1), a1 + hstep, voffA);
            PG8_WAIT_L(8); PG8_BAR; PG8_WAIT_L(0); PG8_MMA(0, 0, At, B0); PG8_BAR; PG8_SCHED;
            PG8_LDB(B1, 0, 1); PG8_STAGE(PG8_SB(0, 0), b2, voffB);
            PG8_BAR; PG8_WAIT_L(0); PG8_MMA(0, 1, At, B1); PG8_BAR;
            PG8_LDA(At, 0, 1); PG8_STAGE(PG8_SA(0, 0), a2, voffA);
            PG8_BAR; PG8_WAIT_L(0); PG8_MMA(1, 0, At, B0); PG8_BAR; PG8_SCHED;
            PG8_STAGE(PG8_SB(0, 1), b2 + hstep, voffB);
            PG8_WAIT_V(6); PG8_BAR; PG8_MMA(1, 1, At, B1); PG8_BAR;
            PG8_LDB(B0, 1, 0); PG8_SCHED; PG8_LDA(At, 1, 0); PG8_STAGE(PG8_SA(0, 1), a2 + hstep, voffA);
            PG8_WAIT_L(8); PG8_BAR; PG8_WAIT_L(0); PG8_MMA(0, 0, At, B0); PG8_BAR; PG8_SCHED;
            PG8_LDB(B1, 1, 1); PG8_STAGE(PG8_SB(1, 0), b3, voffB);
            PG8_BAR; PG8_WAIT_L(0); PG8_MMA(0, 1, At, B1); PG8_BAR;
            PG8_LDA(At, 1, 1); PG8_STAGE(PG8_SA(1, 0), a3, voffA);
            PG8_BAR; PG8_WAIT_L(0); PG8_MMA(1, 0, At, B0); PG8_BAR; PG8_SCHED;
            PG8_STAGE(PG8_SB(1, 1), b3 + hstep, voffB);
            PG8_WAIT_V(6); PG8_BAR; PG8_MMA(1, 1, At, B1); PG8_BAR;
            }
        }
        if constexpr (ALIGN_EPI) { if (wr == 0) PG8_BAR; }
        if constexpr (!Epi::AFTER_DRAIN) { E(acc, cur, wr, wc, fr, fq); S.done(cur); }
        if (!has_next) break;
#pragma unroll
        for (int a = 0; a < 2; ++a)
#pragma unroll
            for (int b = 0; b < 2; ++b)
#pragma unroll
                for (int m = 0; m < 4; ++m)
#pragma unroll
                    for (int n = 0; n < 2; ++n) acc[a][b][m][n] = (f32x4){0.f, 0.f, 0.f, 0.f};
        cur = nxt; cA = nA; cB = nB; ++ui;
        if constexpr (ALIGN_EPI) { if (wr == 1) PG8_BAR; }
    }
    PG8_WAIT_V(0);
    if constexpr (!ALIGN_EPI) { if (wr == 0) PG8_BAR; }
    PG8_BAR;
    if constexpr (Epi::AFTER_DRAIN) { E.fused(acc, cur, wr, wc, fr, fq, lds, wid, lane); S.done(cur); }
#undef PG8_SA
#undef PG8_SB
#undef PG8_STAGE
#undef PG8_LDA
#undef PG8_LDB
#undef PG8_MMA
#undef PG8_WAIT_V
#undef PG8_WAIT_L
#undef PG8_BAR
#undef PG8_SCHED
}
}

#ifndef MK_N_LAUNCHES
#define MK_N_LAUNCHES 1
#endif
constexpr int N_LAUNCHES = MK_N_LAUNCHES;
constexpr int N_PHASES = 8;

constexpr int NWAVES = 8;
constexpr int BATCH = 16, SEQ = 2048, DM = 1024, M = BATCH * SEQ;
constexpr int DIN = 3524, NPROJ = 3584;
constexpr float EPS = 1e-6f;
constexpr float C2 = 0.125f * 1.4426950408889634f;

constexpr size_t MiB = 1u << 20;
constexpr size_t WS_CTL = 0, CTL_ZERO_BYTES = 1 * MiB;
constexpr size_t WS_WIN = 2 * MiB;
constexpr size_t WS_WOUT = 10 * MiB;
constexpr size_t WS_CS = 12 * MiB;
constexpr size_t WS_SSA = 14 * MiB;
constexpr size_t WS_XN = 16 * MiB;
constexpr size_t WS_Y = WS_XN;
constexpr size_t WS_QA = 80 * MiB;
constexpr size_t WS_KA = WS_QA + 32 * MiB, WS_VA = WS_QA + 64 * MiB, WS_ZA = WS_QA + 96 * MiB, WS_QB = WS_QA + 128 * MiB, WS_ZB = WS_QA + 160 * MiB;
constexpr size_t WS_IQ = 272 * MiB;
constexpr size_t WS_MISC = 288 * MiB;
constexpr size_t WS_KB = 320 * MiB;
constexpr size_t WS_VB = 324 * MiB;
constexpr size_t WS_IKN = 356 * MiB;
constexpr size_t WS_IW = 364 * MiB;
constexpr size_t WS_MASK = 366 * MiB;
constexpr size_t WS_END = 376 * MiB;
constexpr int CW_BAR = 4096;

constexpr int LDS_BYTES = 155648;
constexpr int LDSCTL_OFF = LDS_BYTES - 256;

#define GAS __attribute__((address_space(1)))
#define LAS __attribute__((address_space(3)))
typedef unsigned short bf16;
typedef unsigned v4u __attribute__((ext_vector_type(4)));
typedef float f32x4 __attribute__((ext_vector_type(4)));
typedef GAS unsigned gu32;
#define RLX_AGENT __ATOMIC_RELAXED, __HIP_MEMORY_SCOPE_AGENT
__device__ __forceinline__ unsigned f2bf(float f) { unsigned u = __builtin_bit_cast(unsigned, f); return (u + 0x7fffu + ((u >> 16) & 1u)) >> 16; }
__device__ __forceinline__ unsigned pk2(float lo, float hi) { return f2bf(lo) | (f2bf(hi) << 16); }
__device__ __forceinline__ float bf2f(unsigned short h) { return __builtin_bit_cast(float, (unsigned)h << 16); }
__device__ __forceinline__ float bflo(unsigned w) { return __builtin_bit_cast(float, w << 16); }
__device__ __forceinline__ float bfhi(unsigned w) { return __builtin_bit_cast(float, w & 0xffff0000u); }
__device__ __forceinline__ float wave_sum(float v) {
#pragma unroll
    for (int o = 1; o < 64; o <<= 1) v += __shfl_xor(v, o);
    return v;
}
__device__ __forceinline__ float wave_max(float v) {
#pragma unroll
    for (int o = 1; o < 64; o <<= 1) v = fmaxf(v, __shfl_xor(v, o));
    return v;
}

#define XB_TMO      128
#define XB_XCNT(j)  (256  + 64 * (j))
#define XB_XSUB(j)  (1280 + 64 * (j))
#define XB_XGEN(j)  (2304 + 64 * (j))
#define XB_TOP      3328
#define XB_TOPGEN   3392
#define XCD_BAR_WORDS 3456
#define XB_SPIN_CAP (1u << 18)

__device__ __forceinline__ unsigned xb_ld(unsigned* p)              { return __hip_atomic_load(p, __ATOMIC_RELAXED, __HIP_MEMORY_SCOPE_AGENT); }
__device__ __forceinline__ unsigned xb_add(unsigned* p, unsigned v) { return __hip_atomic_fetch_add(p, v, __ATOMIC_RELAXED, __HIP_MEMORY_SCOPE_AGENT); }
__device__ __forceinline__ unsigned xb_xcc_id() { return (unsigned)__builtin_amdgcn_s_getreg((3 << 11) | 20) & 0xFu; }
#define XB_SPIN(cond, bar) do { unsigned _sp = 0; while (cond) { __builtin_amdgcn_s_sleep(1); \
    if ((++_sp & 255u) == 0u) { if (xb_ld(&(bar)[XB_TMO])) break; if (_sp > XB_SPIN_CAP) { atomicAdd(&(bar)[XB_TMO], 1u); break; } } } } while (0)

struct XcdBarrier {
    unsigned* bar; unsigned x;
    volatile LAS unsigned* st;
};

__device__ __forceinline__ XcdBarrier xcd_barrier_post(unsigned* bar, volatile LAS unsigned* st) {
    XcdBarrier b; b.bar = bar; b.x = xb_xcc_id(); b.st = st;
    if (threadIdx.x == 0) (void)xb_add(&bar[XB_XCNT(b.x)], 1u);
    return b;
}
__device__ __forceinline__ void xcd_barrier_complete(unsigned* bar, unsigned x, unsigned& nloc, unsigned& nx) {
    const unsigned G = gridDim.x * gridDim.y * gridDim.z;
    unsigned sum, cnt, mine, sp = 0u;
    for (;;) {
        sum = 0u; cnt = 0u; mine = 0u;
#pragma unroll
        for (unsigned j = 0; j < 16; ++j) { const unsigned c = xb_ld(&bar[XB_XCNT(j)]); sum += c; cnt += (c > 0u) ? 1u : 0u; mine = (j == x) ? c : mine; }
        if (sum == G) break;
        __builtin_amdgcn_s_sleep(1);
        if ((++sp & 255u) == 0u) { if (xb_ld(&bar[XB_TMO])) break; if (sp > XB_SPIN_CAP) { atomicAdd(&bar[XB_TMO], 1u); break; } }
    }
    nloc = mine > 0u ? mine : 1u; nx = cnt > 0u ? cnt : 1u;
}

__device__ __forceinline__ void xcd_barrier(const XcdBarrier& b) {
    asm volatile("s_waitcnt vmcnt(0)" ::: "memory");
    __syncthreads();
    if (threadIdx.x == 0) {
        unsigned* bar = b.bar;
        __builtin_amdgcn_s_waitcnt(0);
        unsigned nloc = b.st[0], nx = b.st[1];
        if (nloc == 0u) { xcd_barrier_complete(bar, b.x, nloc, nx); b.st[0] = nloc; b.st[1] = nx; }
        const unsigned old = xb_add(&bar[XB_XSUB(b.x)], 1u);
        const unsigned gen = old / nloc;
        if (old + 1u == (gen + 1u) * nloc) {
            __builtin_amdgcn_fence(__ATOMIC_RELEASE, "agent");
            asm volatile("s_waitcnt vmcnt(0)" ::: "memory");
            const unsigned og = xb_add(&bar[XB_TOP], 1u);
            const unsigned tg = og / nx;
            if (og + 1u == (tg + 1u) * nx) xb_add(&bar[XB_TOPGEN], 1u);
            else XB_SPIN(xb_ld(&bar[XB_TOPGEN]) == tg, bar);
            __builtin_amdgcn_fence(__ATOMIC_ACQUIRE, "agent");
            xb_add(&bar[XB_XGEN(b.x)], 1u);
            asm volatile("s_waitcnt vmcnt(0)" ::: "memory");
        } else {
            XB_SPIN(xb_ld(&bar[XB_XGEN(b.x)]) == gen, bar);
            __builtin_amdgcn_fence(__ATOMIC_ACQUIRE, "agent");
            asm volatile("s_waitcnt vmcnt(0)" ::: "memory");
        }
    }
    __syncthreads();
}


struct Ctx {
    const float* x; const int* pos; const float* g_in; const float* w_in; const float* g_kv; const float* w_uk; const float* w_uv; const float* g_ik;
    const float* g_a; const float* g_b; const float* w_out; const float* g_fin;
    float* out; unsigned char* ws;
    int tid, lane, wave, G, gw, NGW;
};

namespace pg8 {
__device__ __forceinline__ unsigned cvt_pk_bf16(float lo, float hi) { unsigned r; asm volatile("v_cvt_pk_bf16_f32 %0, %1, %2" : "=v"(r) : "v"(lo), "v"(hi)); return r; }
struct EpiProj {
    static constexpr bool PERM = true, AFTER_DRAIN = false;
    unsigned char* ws; const float* cs;
    __device__ __forceinline__ void operator()(const f32x4 (&acc)[2][2][4][2], const Unit& u, int wr, int wc, int fr, int fq) const {
        const int pn = u.pn;
        const int row0 = u.pm * BM + wr * 64 + fr;
        if (pn == 13) {
            float* base = (float*)(ws + WS_MISC) + wc * 32 + 8 * fq;
#pragma unroll
            for (int ai = 0; ai < 2; ++ai)
#pragma unroll
                for (int m = 0; m < 4; ++m) { float* rowp = base + (size_t)(row0 + ai * HALF + m * 16) * 256;
#pragma unroll
                    for (int bj = 0; bj < 2; ++bj) { *(f32x4*)(rowp + bj * HALF) = acc[ai][bj][m][0]; *(f32x4*)(rowp + bj * HALF + 4) = acc[ai][bj][m][1]; } }
            return;
        }
        bf16_t* base; int ld;
        if (pn == 12) { base = (bf16_t*)(ws + WS_IQ); ld = 256; }
        else { base = (bf16_t*)(ws + WS_QA + (size_t)(pn >> 1) * (32 * MiB)) + (pn & 1) * 256; ld = 512; }
        const bool rope = (pn < 4) || (pn == 8) || (pn == 9) || (pn == 12);
        const float sc = (pn < 2 || pn == 8 || pn == 9) ? C2 : 1.0f;
        const bool ropew = rope && ((wc & 1) == 0);
        base += wc * 32 + 8 * fq;
#pragma unroll
        for (int ai = 0; ai < 2; ++ai)
#pragma unroll
            for (int m = 0; m < 4; ++m) {
                const int row = row0 + ai * HALF + m * 16;
                bf16_t* rowp = base + (size_t)row * ld;
                f32x4 c0 = {1.f, 1.f, 1.f, 1.f}, c1 = c0, s0 = {0.f, 0.f, 0.f, 0.f}, s1 = s0;
                if (ropew) { const f32x4* cp = (const f32x4*)(cs + (size_t)row * 16); c0 = cp[0]; c1 = cp[1]; s0 = cp[2]; s1 = cp[3]; if (fq == 0) { s0 = -s0; s1 = -s1; } if (fq >= 2) { c0 = (f32x4){1.f, 1.f, 1.f, 1.f}; c1 = c0; s0 = (f32x4){0.f, 0.f, 0.f, 0.f}; s1 = s0; } }
#pragma unroll
                for (int bj = 0; bj < 2; ++bj) {
                    f32x4 v0 = acc[ai][bj][m][0], v1 = acc[ai][bj][m][1];
                    if (ropew) {
                        f32x4 p0, p1;
#pragma unroll
                        for (int e = 0; e < 4; ++e) { p0[e] = __shfl_xor(v0[e], 16); p1[e] = __shfl_xor(v1[e], 16); }
                        v0 = v0 * c0 + p0 * s0; v1 = v1 * c1 + p1 * s1;
                    }
                    v0 = v0 * sc; v1 = v1 * sc;
                    u32x4 w; w.x = cvt_pk_bf16(v0[0], v0[1]); w.y = cvt_pk_bf16(v0[2], v0[3]); w.z = cvt_pk_bf16(v1[0], v1[1]); w.w = cvt_pk_bf16(v1[2], v1[3]);
                    *(u32x4*)(rowp + bj * HALF) = w;
                }
            }
    }
};
struct EpiOut {
    static constexpr bool PERM = false, AFTER_DRAIN = false;
    const float* x; float* out; const float* ssa;
    __device__ __forceinline__ void operator()(const f32x4 (&acc)[2][2][4][2], const Unit& u, int wr, int wc, int fr, int fq) const {
        const int col0 = u.pn * BM + wc * 32 + 4 * fq;
#pragma unroll
        for (int ai = 0; ai < 2; ++ai)
#pragma unroll
            for (int m = 0; m < 4; ++m) {
                const int r = u.pm * BM + ai * HALF + wr * 64 + m * 16 + fr;
                const f32x4 a0 = *(const f32x4*)(ssa + (size_t)r * 8), a1 = *(const f32x4*)(ssa + (size_t)r * 8 + 4);
                const float ss = ((a0[0] + a0[1]) + (a0[2] + a0[3])) + ((a1[0] + a1[1]) + (a1[2] + a1[3]));
                const float rs = 1.0f / sqrtf(ss * (1.0f / 512.0f) + EPS);
                const size_t off = (size_t)r * DM + col0;
#pragma unroll
                for (int bj = 0; bj < 2; ++bj)
#pragma unroll
                    for (int n = 0; n < 2; ++n) { const f32x4 xv = *(const f32x4*)(x + off + bj * HALF + n * 16); *(f32x4*)(out + off + bj * HALF + n * 16) = xv + acc[ai][bj][m][n] * rs; }
            }
    }
};
}

__device__ __forceinline__ void p0_transpose_item(const float* W, int ldw, int srccol0, int nvalid, const float* rowgain, bf16* WT, int K, int n0, int k0, LAS float* scr, int lane) {
#pragma unroll 8
    for (int i = 0; i < 32; ++i) { const int kk = 2 * i + (lane >> 5), n = lane & 31; float v = 0.f; if (n < nvalid) { v = W[(size_t)(k0 + kk) * ldw + srccol0 + n]; if (rowgain) v *= rowgain[k0 + kk]; } scr[kk * 33 + n] = v; }
    asm volatile("s_waitcnt lgkmcnt(0)" ::: "memory");
    const int c = lane & 7;
#pragma unroll
    for (int j = 0; j < 4; ++j) { const int n = (lane >> 3) + 8 * j; const LAS float* s = scr + (8 * c) * 33 + n;
        v4u o; o.x = pk2(s[0 * 33], s[1 * 33]); o.y = pk2(s[2 * 33], s[3 * 33]); o.z = pk2(s[4 * 33], s[5 * 33]); o.w = pk2(s[6 * 33], s[7 * 33]);
        *(GAS v4u*)(WT + (size_t)(n0 + n) * K + k0 + 8 * c) = o; }
    asm volatile("s_waitcnt lgkmcnt(0)" ::: "memory");
}
__device__ __forceinline__ void p0_prologue(const Ctx& C, LAS unsigned char* lds) {
    LAS float* scr = (LAS float*)(lds + C.wave * 16384);
    constexpr int I1 = 16 * (NPROJ / 32), I2 = 16 * (DM / 32);
    for (int it = C.gw; it < I1 + I2; it += C.NGW) {
        if (it < I1) {
            const int kb = it / (NPROJ / 32), nb = it % (NPROJ / 32), n0 = 32 * nb;
            int src;
            if (n0 < 2560) src = n0; else if (n0 < 3072) src = 2688 + (n0 - 2560); else if (n0 < 3328) src = 3200 + (n0 - 3072); else if (n0 < 3456) src = 2560 + (n0 - 3328); else src = n0;
            const int nvalid = (n0 + 32 <= DIN) ? 32 : (n0 < DIN ? DIN - n0 : 0);
            p0_transpose_item(C.w_in, DIN, src, nvalid, nullptr, (bf16*)(C.ws + WS_WIN), DM, n0, 64 * kb, scr, C.lane);
        } else {
            const int r = it - I1, kb = r / (DM / 32), nb = r % (DM / 32);
            const float* gain = (kb < 8) ? C.g_a : (C.g_b - 512);
            p0_transpose_item(C.w_out, DM, 32 * nb, 32, gain, (bf16*)(C.ws + WS_WOUT), DM, 32 * nb, 64 * kb, scr, C.lane);
        }
    }
    for (int m = C.gw; m < M; m += C.NGW) {
        const GAS f32x4* xr = (const GAS f32x4*)(C.x + (size_t)m * DM) + C.lane;
        const GAS f32x4* gr = (const GAS f32x4*)C.g_in + C.lane;
        f32x4 v[4]; float s = 0.f;
#pragma unroll
        for (int j = 0; j < 4; ++j) { v[j] = xr[64 * j]; s += (v[j].x * v[j].x + v[j].y * v[j].y) + (v[j].z * v[j].z + v[j].w * v[j].w); }
        const float rs = 1.0f / sqrtf(wave_sum(s) * (1.0f / DM) + EPS);
        GAS unsigned long long* o8 = (GAS unsigned long long*)((bf16*)(C.ws + WS_XN) + (size_t)m * DM) + C.lane;
#pragma unroll
        for (int j = 0; j < 4; ++j) { const f32x4 g = gr[64 * j]; o8[64 * j] = (unsigned long long)pk2(v[j].x * rs * g.x, v[j].y * rs * g.y) | ((unsigned long long)pk2(v[j].z * rs * g.z, v[j].w * rs * g.w) << 32); }
    }
    for (int e = blockIdx.x * (NWAVES * 64) + C.tid; e < M * 8; e += C.G * NWAVES * 64) {
        const int tok = e >> 3, j = e & 7;
        const float inv = exp2f(-(float)j * (18.931568569324174f / 8.0f));
        const float ang = (float)C.pos[tok] * inv;
        const double rev = (double)ang * 0.15915494309189535;
        const float fr = (float)(rev - rint(rev));
        float* cs = (float*)(C.ws + WS_CS) + (size_t)tok * 16;
        cs[j] = __builtin_amdgcn_cosf(fr); cs[8 + j] = __builtin_amdgcn_sinf(fr);
    }
}

__device__ __forceinline__ void p2_token_local(const Ctx& C, LAS unsigned char* lds) {
    LAS float* ck = (LAS float*)(lds + C.wave * 16384);
    const int lane = C.lane;
    const float* misc = (const float*)(C.ws + WS_MISC);
    const float* cs = (const float*)(C.ws + WS_CS);
    for (int grp = C.gw; grp < M / 8; grp += C.NGW) {
        const int tok0 = grp * 8;
#pragma unroll 1
        for (int tt = 0; tt < 8; ++tt) {
            const int tok = tok0 + tt; const float* mr = misc + (size_t)tok * 256;
            const float a = mr[2 * lane], b = mr[2 * lane + 1];
            const float rs = 1.0f / sqrtf(wave_sum(a * a + b * b) * (1.0f / 128.0f) + EPS);
            ck[tt * 128 + 2 * lane] = a * rs * C.g_kv[2 * lane]; ck[tt * 128 + 2 * lane + 1] = b * rs * C.g_kv[2 * lane + 1];
            const float k = mr[128 + lane];
            const float rk = 1.0f / sqrtf(wave_sum(k * k) * (1.0f / 64.0f) + EPS);
            float kn = k * rk * C.g_ik[lane];
            const float partner = __shfl_xor(kn, 8);
            if (lane < 16) { const float c = cs[(size_t)tok * 16 + (lane & 7)], s = cs[(size_t)tok * 16 + 8 + (lane & 7)]; kn = (lane < 8) ? kn * c - partner * s : kn * c + partner * s; }
            ((bf16*)(C.ws + WS_IKN))[(size_t)tok * 64 + lane] = (bf16)f2bf(kn);
            if (lane < 4) ((float*)(C.ws + WS_IW))[(size_t)tok * 4 + lane] = mr[192 + lane] * 0.0625f;
        }
        asm volatile("s_waitcnt lgkmcnt(0)" ::: "memory");
        float acc[9][8];
#pragma unroll
        for (int i = 0; i < 9; ++i)
#pragma unroll
            for (int t = 0; t < 8; ++t) acc[i][t] = 0.f;
#pragma unroll 2
        for (int c = 0; c < 128; ++c) {
            float w[9]; w[0] = C.w_uk[c * 64 + lane];
#pragma unroll
            for (int h = 0; h < 8; ++h) w[1 + h] = C.w_uv[(size_t)(h * 128 + c) * 64 + lane];
#pragma unroll
            for (int t = 0; t < 8; ++t) { const float a = ck[t * 128 + c];
#pragma unroll
                for (int i = 0; i < 9; ++i) acc[i][t] += a * w[i]; }
        }
#pragma unroll
        for (int t = 0; t < 8; ++t) {
            const int tok = tok0 + t;
            float kb = acc[0][t];
            const float partner = __shfl_xor(kb, 8);
            if (lane < 16) { const float c = cs[(size_t)tok * 16 + (lane & 7)], s = cs[(size_t)tok * 16 + 8 + (lane & 7)]; kb = (lane < 8) ? kb * c - partner * s : kb * c + partner * s; }
            ((bf16*)(C.ws + WS_KB))[(size_t)tok * 64 + lane] = (bf16)f2bf(kb);
#pragma unroll
            for (int h = 0; h < 8; ++h) ((bf16*)(C.ws + WS_VB))[(size_t)tok * 512 + h * 64 + lane] = (bf16)f2bf(acc[1 + h][t]);
        }
        asm volatile("s_waitcnt lgkmcnt(0)" ::: "memory");
    }
}

__device__ __forceinline__ void select_topk(const LAS float* srow, int t, unsigned long long* maskrow, int lane) {
    unsigned key[32];
#pragma unroll
    for (int j = 0; j < 32; ++j) { const int s = 64 * j + lane; unsigned u = 0u; if (s <= t) { const unsigned f = __float_as_uint(srow[s]); u = (f & 0x80000000u) ? ~f : (f | 0x80000000u); } key[j] = u; }
    const int nregs = (t >> 6) + 1;
    unsigned long long myword = 0ull;
    if (t + 1 <= 256) {
#pragma unroll
        for (int j = 0; j < 32; ++j) { const unsigned long long b = __builtin_amdgcn_ballot_w64(key[j] != 0u); if (lane == j) myword = b; }
    } else {
        unsigned T = 0u; bool exact = false;
        for (int bit = 31; bit >= 0; --bit) {
            const unsigned cand = T | (1u << bit);
            int c = 0;
#pragma unroll
            for (int j = 0; j < 32; ++j) if (j < nregs) c += __builtin_popcountll(__builtin_amdgcn_ballot_w64(key[j] >= cand));
            if (c >= 256) { T = cand; if (c == 256) { exact = true; break; } }
        }
        if (exact) {
#pragma unroll
            for (int j = 0; j < 32; ++j) { const unsigned long long b = __builtin_amdgcn_ballot_w64(key[j] >= T); if (lane == j) myword = b; }
        } else {
            int cgt = 0;
#pragma unroll
            for (int j = 0; j < 32; ++j) cgt += __builtin_popcountll(__builtin_amdgcn_ballot_w64(key[j] > T));
            const int r = 256 - cgt; int running = 0;
            const unsigned long long ltmask = (1ull << lane) - 1ull;
#pragma unroll
            for (int j = 0; j < 32; ++j) {
                const unsigned long long eq = __builtin_amdgcn_ballot_w64(key[j] == T);
                const int pre = running + __builtin_popcountll(eq & ltmask);
                const bool s = (key[j] > T) || (key[j] == T && pre < r);
                const unsigned long long b = __builtin_amdgcn_ballot_w64(s);
                if (lane == j) myword = b;
                running += __builtin_popcountll(eq);
            }
        }
    }
    if (lane < 32) maskrow[lane] = myword;
}
__device__ __forceinline__ void p3_indexer(const Ctx& C, LAS unsigned char* lds) {
    LAS float* scores = (LAS float*)lds;
    LAS float* iql = (LAS float*)(lds + 131072);
    LAS float* iwl = (LAS float*)(lds + 131072 + 16384);
    const bf16* IQ = (const bf16*)(C.ws + WS_IQ); const bf16* IKN = (const bf16*)(C.ws + WS_IKN); const float* IW = (const float*)(C.ws + WS_IW);
    unsigned long long* MASK = (unsigned long long*)(C.ws + WS_MASK);
    for (int unit = blockIdx.x; unit < BATCH * (SEQ / 16); unit += C.G) {
        const int b = unit / (SEQ / 16), t0 = (unit % (SEQ / 16)) * 16; const size_t tokb = (size_t)b * SEQ;
        {
            const int idx = C.tid * 8; const v4u w = *(const GAS v4u*)(IQ + (tokb + t0 + (idx >> 8)) * 256 + (idx & 255));
            LAS float* d = iql + idx; d[0] = bflo(w.x); d[1] = bfhi(w.x); d[2] = bflo(w.y); d[3] = bfhi(w.y); d[4] = bflo(w.z); d[5] = bfhi(w.z); d[6] = bflo(w.w); d[7] = bfhi(w.w);
            if (C.tid < 64) iwl[C.tid] = IW[(tokb + t0) * 4 + C.tid];
        }
        __syncthreads();
        const int nkeys = t0 + 16;
        for (int s = C.tid; s < nkeys; s += NWAVES * 64) {
            float k[64];
            const GAS v4u* kp = (const GAS v4u*)(IKN + (tokb + s) * 64);
#pragma unroll
            for (int i = 0; i < 8; ++i) { const v4u w = kp[i]; k[8 * i] = bflo(w.x); k[8 * i + 1] = bfhi(w.x); k[8 * i + 2] = bflo(w.y); k[8 * i + 3] = bfhi(w.y); k[8 * i + 4] = bflo(w.z); k[8 * i + 5] = bfhi(w.z); k[8 * i + 6] = bflo(w.w); k[8 * i + 7] = bfhi(w.w); }
#pragma unroll 1
            for (int q = 0; q < 16; ++q) {
                float sc = 0.f;
#pragma unroll
                for (int h = 0; h < 4; ++h) {
                    const LAS f32x4* qp = (const LAS f32x4*)(iql + q * 256 + h * 64);
                    float d0 = 0.f, d1 = 0.f;
#pragma unroll
                    for (int i = 0; i < 16; ++i) { const f32x4 qv = qp[i]; d0 += qv.x * k[4 * i] + qv.z * k[4 * i + 2]; d1 += qv.y * k[4 * i + 1] + qv.w * k[4 * i + 3]; }
                    sc += iwl[q * 4 + h] * fmaxf(d0 + d1, 0.f);
                }
                scores[q * 2048 + s] = sc;
            }
        }
        __syncthreads();
#pragma unroll 1
        for (int qq = 0; qq < 2; ++qq) { const int q = C.wave * 2 + qq, t = t0 + q; select_topk(scores + q * 2048, t, MASK + (tokb + t) * 32, C.lane); }
        __syncthreads();
    }
}

__device__ __forceinline__ void p4_mixer_a(const Ctx& C) {
    const bf16* QA = (const bf16*)(C.ws + WS_QA); const bf16* KA = (const bf16*)(C.ws + WS_KA); const bf16* VA = (const bf16*)(C.ws + WS_VA); const bf16* ZA = (const bf16*)(C.ws + WS_ZA);
    bf16* Y = (bf16*)(C.ws + WS_Y); float* SSA = (float*)(C.ws + WS_SSA);
    const int lane = C.lane;
    for (int job = C.gw; job < M * 8; job += C.NGW) {
        const int tok = job >> 3, h = job & 7, b = tok / SEQ, t = tok % SEQ; const size_t tokb = (size_t)b * SEQ;
        float qf[64];
        { const GAS v4u* qp = (const GAS v4u*)(QA + (size_t)tok * 512 + h * 64);
#pragma unroll
          for (int i = 0; i < 8; ++i) { const v4u w = qp[i]; qf[8 * i] = bflo(w.x); qf[8 * i + 1] = bfhi(w.x); qf[8 * i + 2] = bflo(w.y); qf[8 * i + 3] = bfhi(w.y); qf[8 * i + 4] = bflo(w.z); qf[8 * i + 5] = bfhi(w.z); qf[8 * i + 6] = bflo(w.w); qf[8 * i + 7] = bfhi(w.w); } }
        float sv[7]; int pv[7]; float mx = -INFINITY;
#pragma unroll
        for (int i = 0; i < 7; ++i) {
            const int e = lane + 64 * i; int d, j;
            if (e < 129) { d = 1; j = e; } else if (e < 258) { d = 4; j = e - 129; } else { d = 16; j = e - 258; }
            const int p = t - j * d; const bool valid = (e < 387) && (p >= 0);
            float s = -INFINITY;
            if (valid) { const GAS v4u* kp = (const GAS v4u*)(KA + (tokb + p) * 512 + h * 64); float a0 = 0.f, a1 = 0.f;
#pragma unroll
                for (int c = 0; c < 8; ++c) { const v4u w = kp[c]; a0 += qf[8 * c] * bflo(w.x) + qf[8 * c + 2] * bflo(w.y) + qf[8 * c + 4] * bflo(w.z) + qf[8 * c + 6] * bflo(w.w); a1 += qf[8 * c + 1] * bfhi(w.x) + qf[8 * c + 3] * bfhi(w.y) + qf[8 * c + 5] * bfhi(w.z) + qf[8 * c + 7] * bfhi(w.w); }
                s = a0 + a1; }
            sv[i] = s; pv[i] = valid ? p : 0; mx = fmaxf(mx, s);
        }
        mx = wave_max(mx);
        float lsum = 0.f;
#pragma unroll
        for (int i = 0; i < 7; ++i) { sv[i] = exp2f(sv[i] - mx); lsum += sv[i]; }
        lsum = wave_sum(lsum);
        float o = 0.f;
        const bf16* vcol = VA + tokb * 512 + h * 64 + lane;
#pragma unroll
        for (int i = 0; i < 7; ++i) {
            const int cnt = (i < 6) ? 64 : 3;
#pragma unroll 8
            for (int l2 = 0; l2 < cnt; ++l2) { const float pp = __builtin_bit_cast(float, __builtin_amdgcn_readlane(__builtin_bit_cast(int, sv[i]), l2)); const int ps = __builtin_amdgcn_readlane(pv[i], l2);
                o += pp * bf2f(vcol[(size_t)ps * 512]); }
        }
        o = o / lsum;
        const float z = bf2f(ZA[(size_t)tok * 512 + h * 64 + lane]);
        const float v = o * z / (1.0f + __expf(-z));
        const float ss = wave_sum(v * v);
        if (lane == 0) SSA[(size_t)tok * 8 + h] = ss;
        Y[(size_t)tok * DM + h * 64 + lane] = (bf16)f2bf(v);
    }
}

__device__ __forceinline__ void p5_mixer_b(const Ctx& C, LAS unsigned char* lds) {
    const bf16* QB = (const bf16*)(C.ws + WS_QB); const bf16* KB = (const bf16*)(C.ws + WS_KB); const bf16* VB = (const bf16*)(C.ws + WS_VB); const bf16* ZB = (const bf16*)(C.ws + WS_ZB);
    const unsigned long long* MASK = (const unsigned long long*)(C.ws + WS_MASK);
    bf16* Y = (bf16*)(C.ws + WS_Y); const float* SSA = (const float*)(C.ws + WS_SSA);
    LAS float* red = (LAS float*)lds;
    const int lane = C.lane, h = C.wave;
    for (int tok = blockIdx.x; tok < M; tok += C.G) {
        const int b = tok / SEQ, t = tok % SEQ; const size_t tokb = (size_t)b * SEQ;
        float qf[64];
        { const GAS v4u* qp = (const GAS v4u*)(QB + (size_t)tok * 512 + h * 64);
#pragma unroll
          for (int i = 0; i < 8; ++i) { const v4u w = qp[i]; qf[8 * i] = bflo(w.x); qf[8 * i + 1] = bfhi(w.x); qf[8 * i + 2] = bflo(w.y); qf[8 * i + 3] = bfhi(w.y); qf[8 * i + 4] = bflo(w.z); qf[8 * i + 5] = bfhi(w.z); qf[8 * i + 6] = bflo(w.w); qf[8 * i + 7] = bfhi(w.w); } }
        const int nw = (t >> 6) + 1;
        float sv[32]; float mx = -INFINITY;
#pragma unroll
        for (int j = 0; j < 32; ++j) {
            float s = -INFINITY;
            if (j < nw) {
                const unsigned long long w = MASK[(size_t)tok * 32 + j];
                if ((w >> lane) & 1ull) { const GAS v4u* kp = (const GAS v4u*)(KB + (tokb + 64 * j + lane) * 64); float a0 = 0.f, a1 = 0.f;
#pragma unroll
                    for (int c = 0; c < 8; ++c) { const v4u x = kp[c]; a0 += qf[8 * c] * bflo(x.x) + qf[8 * c + 2] * bflo(x.y) + qf[8 * c + 4] * bflo(x.z) + qf[8 * c + 6] * bflo(x.w); a1 += qf[8 * c + 1] * bfhi(x.x) + qf[8 * c + 3] * bfhi(x.y) + qf[8 * c + 5] * bfhi(x.z) + qf[8 * c + 7] * bfhi(x.w); }
                    s = a0 + a1; }
            }
            sv[j] = s; mx = fmaxf(mx, s);
        }
        mx = wave_max(mx);
        float lsum = 0.f;
#pragma unroll
        for (int j = 0; j < 32; ++j) { sv[j] = exp2f(sv[j] - mx); lsum += sv[j]; }
        lsum = wave_sum(lsum);
        float o = 0.f;
        const bf16* vcol = VB + tokb * 512 + h * 64 + lane;
#pragma unroll
        for (int j = 0; j < 32; ++j) {
            if (j < nw) {
                const unsigned long long wv = MASK[(size_t)tok * 32 + j];
                unsigned wlo = __builtin_amdgcn_readfirstlane((unsigned)wv), whi = __builtin_amdgcn_readfirstlane((unsigned)(wv >> 32));
                unsigned long long w = ((unsigned long long)whi << 32) | wlo;
                while (w) { const int l2 = __builtin_ctzll(w); w &= w - 1ull;
                    const float pp = __builtin_bit_cast(float, __builtin_amdgcn_readlane(__builtin_bit_cast(int, sv[j]), l2));
                    o += pp * bf2f(vcol[(size_t)(64 * j + l2) * 512]); }
            }
        }
        o = o / lsum;
        const float z = bf2f(ZB[(size_t)tok * 512 + h * 64 + lane]);
        const float v = o * z / (1.0f + __expf(-z));
        const float ss = wave_sum(v * v);
        if (lane == 0) red[h] = ss;
        __syncthreads();
        float ssb = 0.f, ssa = 0.f;
#pragma unroll
        for (int i = 0; i < 8; ++i) { ssb += red[i]; ssa += SSA[(size_t)tok * 8 + i]; }
        const float rsb = 1.0f / sqrtf(ssb * (1.0f / 512.0f) + EPS), rsa = 1.0f / sqrtf(ssa * (1.0f / 512.0f) + EPS);
        Y[(size_t)tok * DM + 512 + h * 64 + lane] = (bf16)f2bf(v * rsb / rsa);
        __syncthreads();
    }
}

__device__ __forceinline__ void p7_final_norm(const Ctx& C) {
    for (int m = C.gw; m < M; m += C.NGW) {
        GAS f32x4* xr = (GAS f32x4*)(C.out + (size_t)m * DM) + C.lane;
        const GAS f32x4* gr = (const GAS f32x4*)C.g_fin + C.lane;
        f32x4 v[4]; float s = 0.f;
#pragma unroll
        for (int j = 0; j < 4; ++j) { v[j] = xr[64 * j]; s += (v[j].x * v[j].x + v[j].y * v[j].y) + (v[j].z * v[j].z + v[j].w * v[j].w); }
        const float rs = 1.0f / sqrtf(wave_sum(s) * (1.0f / DM) + EPS);
#pragma unroll
        for (int j = 0; j < 4; ++j) xr[64 * j] = v[j] * rs * gr[64 * j];
    }
}

struct Args { const void* in[12]; float* out; unsigned char* ws; int ph_lo, ph_hi, li, pad; };
__global__ void __launch_bounds__(NWAVES * 64, 2) mk_fwd(Args args) {
    extern __shared__ __attribute__((aligned(16))) unsigned char lds_raw[];
    LAS unsigned char* lds = (LAS unsigned char*)lds_raw;
    Ctx C;
    C.x = (const float*)args.in[0]; C.pos = (const int*)args.in[1]; C.g_in = (const float*)args.in[2]; C.w_in = (const float*)args.in[3]; C.g_kv = (const float*)args.in[4];
    C.w_uk = (const float*)args.in[5]; C.w_uv = (const float*)args.in[6]; C.g_ik = (const float*)args.in[7]; C.g_a = (const float*)args.in[8]; C.g_b = (const float*)args.in[9];
    C.w_out = (const float*)args.in[10]; C.g_fin = (const float*)args.in[11]; C.out = args.out; C.ws = args.ws;
    C.tid = threadIdx.x; C.lane = C.tid & 63; C.wave = __builtin_amdgcn_readfirstlane(C.tid >> 6); C.G = gridDim.x;
    C.gw = blockIdx.x * NWAVES + C.wave; C.NGW = C.G * NWAVES;
    volatile LAS unsigned* LCTL = (volatile LAS unsigned*)(lds + LDSCTL_OFF);
    if (C.tid < 64) LCTL[C.tid] = 0u;
    __syncthreads();
    gu32* ctl = (gu32*)(args.ws + WS_CTL);
    XcdBarrier bar; bar.bar = (unsigned*)(ctl + CW_BAR); bar.x = 0; bar.st = nullptr;
    if (N_LAUNCHES == 1) bar = xcd_barrier_post((unsigned*)(ctl + CW_BAR), LCTL);
    const int lo = args.ph_lo, hi = args.ph_hi;
#define IN(k) (lo <= (k) && (k) < hi)
#define SEAM(k) do { if (IN(k) && IN((k) + 1)) xcd_barrier(bar); } while (0)

    if (IN(0)) { p0_prologue(C, lds); SEAM(0); }
    if (IN(1)) {
        pg8::Gemm g{(const pg8::bf16_t*)(C.ws + WS_XN), (const pg8::bf16_t*)(C.ws + WS_WIN), M, NPROJ, DM}; pg8::StaticOrder S; S.init(M, NPROJ, C.G, (int)blockIdx.x);
        pg8::EpiProj E{C.ws, (const float*)(C.ws + WS_CS)};
        pg8::gemm_phase<pg8::EpiProj, pg8::StaticOrder, true, true>(lds, g, S, E);
        SEAM(1);
    }
    if (IN(2)) { p2_token_local(C, lds); SEAM(2); }
    if (IN(3)) { p3_indexer(C, lds); }
    if (IN(4)) { p4_mixer_a(C); SEAM(4); }
    if (IN(5)) { p5_mixer_b(C, lds); SEAM(5); }
    if (IN(6)) {
        pg8::Gemm g{(const pg8::bf16_t*)(C.ws + WS_Y), (const pg8::bf16_t*)(C.ws + WS_WOUT), M, DM, DM}; pg8::StaticOrder S; S.init(M, DM, C.G, (int)blockIdx.x);
        pg8::EpiOut E{C.x, C.out, (const float*)(C.ws + WS_SSA)};
        pg8::gemm_phase<pg8::EpiOut, pg8::StaticOrder, true, true>(lds, g, S, E);
        SEAM(6);
    }
    if (IN(7)) { p7_final_norm(C); }
#undef IN
#undef SEAM
}

extern "C" void kernel_launch(void* const* d_in, const int* in_sizes, int n_in, void* d_out, int out_size, void* d_ws, size_t ws_size, hipStream_t stream) {
    static int grid = 0;
    if (grid == 0) {
        if (n_in != 12 || in_sizes[0] != M * DM || out_size != M * DM || ws_size < WS_END) { fprintf(stderr, "kernel_launch: unexpected shapes (n_in %d, in0 %d, out %d, ws %zu)\n", n_in, n_in > 0 ? in_sizes[0] : -1, out_size, ws_size); grid = -1; return; }
        int dev = 0, cus = 0, per_cu = 0;
        if (hipGetDevice(&dev) != hipSuccess || hipDeviceGetAttribute(&cus, hipDeviceAttributeMultiprocessorCount, dev) != hipSuccess) { grid = -1; return; }
        if (hipFuncSetAttribute((const void*)mk_fwd, hipFuncAttributeMaxDynamicSharedMemorySize, LDS_BYTES) != hipSuccess) { fprintf(stderr, "kernel_launch: hipFuncSetAttribute failed\n"); grid = -1; return; }
        if (hipOccupancyMaxActiveBlocksPerMultiprocessor(&per_cu, (const void*)mk_fwd, NWAVES * 64, LDS_BYTES) != hipSuccess || per_cu < 1) fprintf(stderr, "kernel_launch: occupancy query reports %d\n", per_cu);
        (void)hipGetLastError();
        grid = cus;
    }
    if (grid < 0) return;
    if (hipMemsetAsync((char*)d_ws + WS_CTL, 0, CTL_ZERO_BYTES, stream) != hipSuccess) return;
    Args a{};
    for (int i = 0; i < 12; ++i) a.in[i] = d_in[i];
    a.out = (float*)d_out; a.ws = (unsigned char*)d_ws;
    for (int li = 0; li < N_LAUNCHES; ++li) {
        a.ph_lo = (N_LAUNCHES == 1) ? 0 : li; a.ph_hi = (N_LAUNCHES == 1) ? N_PHASES : li + 1; a.li = li;
        hipLaunchKernelGGL(mk_fwd, dim3(grid), dim3(NWAVES * 64), LDS_BYTES, stream, a);
        const hipError_t le = hipPeekAtLastError();
        if (le != hipSuccess) { fprintf(stderr, "kernel_launch: launch %d failed: %s\n", li, hipGetErrorName(le)); break; }
    }
}
```

```cpp
#include <hip/hip_runtime.h>
#include <cstdio>
#include <cstdint>
namespace pg8 {
#define PG8_LAS __attribute__((address_space(3)))
typedef unsigned short bf16_t;
typedef short bf16x8 __attribute__((ext_vector_type(8)));
typedef float f32x4 __attribute__((ext_vector_type(4)));
typedef unsigned u32x4 __attribute__((ext_vector_type(4)));
constexpr int BM = 256, BK = 64, HALF = 128, HTB = HALF * BK * 2  , STAGE_BYTES = 8 * HTB, NXCD = 8, WGM = 8;

__host__ __device__ __forceinline__ int lds_byte(int r, int c) { const int st = (r >> 4) * 2 + (c >> 5), rr = r & 15, cc = c & 31, ob = rr * 64 + cc * 2; return st * 1024 + (ob ^ (((ob >> 9) & 1) << 5)); }
__host__ __device__ __forceinline__ void stage_rc(int b, int& R, int& C) { const int st = b / 1024, sb = b % 1024, swz = sb ^ (((sb >> 9) & 1) << 5); R = (st >> 1) * 16 + swz / 64; C = (st & 1) * 32 + (swz % 64) / 2; }
__host__ __device__ __forceinline__ int perm32(int rho) { const int n = rho >> 4, i = rho & 15; return 8 * (i >> 2) + 4 * n + (i & 3); }

struct Unit { int pm, pn; };
struct Gemm { const bf16_t* A; const bf16_t* Bt; int M, N, K; };

struct StaticOrder {
    int nM, nN, nwg, G, c;
    __host__ __device__ void init(int M, int N, int G_, int c_) { nM = M / BM; nN = N / BM; nwg = nM * nN; G = G_; c = c_; }
    __host__ __device__ bool next(int i, Unit& u) const {
        const long L = (long)i * G + c; if (L >= nwg) return false;
        int wgid = (int)L; { const int q = nwg / NXCD, r = nwg % NXCD, xcd = wgid % NXCD, off = wgid / NXCD; wgid = (xcd < r ? xcd * (q + 1) : r * (q + 1) + (xcd - r) * q) + off; }
        const int nig = WGM * nN, gid = wgid / nig, fm = gid * WGM, gsz = (nM - fm) < WGM ? (nM - fm) : WGM;
        u.pm = fm + ((wgid % nig) % gsz); u.pn = (wgid % nig) / gsz; return true;
    }
    __device__ __forceinline__ void a_ready(const Unit&) const {}
    __device__ __forceinline__ void done(const Unit&) const {}
};

template <class Epi, class Sched, bool ALIGN_EPI = false, bool SP2 = false>
__device__ __forceinline__ void gemm_phase(PG8_LAS unsigned char* lds, const Gemm g, const Sched& S, const Epi& E) {
    const int tid = threadIdx.x, wid = __builtin_amdgcn_readfirstlane(tid >> 6), lane = tid & 63, wr = wid >> 2, wc = wid & 3, fr = lane & 15, fq = lane >> 4;
    const int K = g.K, nt = K / BK;
    unsigned voffA[2], voffB[2];
#pragma unroll
    for (int i = 0; i < 2; ++i) { int R, C; stage_rc(tid * 16 + i * 8192, R, C); const int Rb = Epi::PERM ? ((R & ~31) + perm32(R & 31)) : R;
        voffA[i] = (unsigned)(R * K + C) * 2u; voffB[i] = (unsigned)(Rb * K + C) * 2u; }
    const size_t kstep = (size_t)(BK * 2);
    const size_t hstep = (size_t)HALF * K * 2;
    const size_t tstep = 2 * hstep;
    const unsigned ldsw = (unsigned)wid * 1024u;
    const int aoff = lds_byte(wr * 64 + fr, fq * 8), boff = lds_byte(wc * 32 + fr, fq * 8);
#define PG8_SA(b, h) (((b) * 2 + (h)) * HTB)
#define PG8_SB(b, h) ((4 + (b) * 2 + (h)) * HTB)
#define PG8_STAGE(bufoff, gbase, voff) do { _Pragma("unroll") for (int _i = 0; _i < 2; ++_i) \
        __builtin_amdgcn_global_load_lds((const unsigned*)((const char*)(gbase) + (voff)[_i]), (PG8_LAS unsigned*)(lds + (bufoff) + ldsw + _i * 8192), 16, 0, 0); } while (0)
#define PG8_LDA(dst, b, h) do { _Pragma("unroll") for (int m = 0; m < 4; ++m) _Pragma("unroll") for (int k = 0; k < 2; ++k) dst[m][k] = *(const PG8_LAS bf16x8*)(lds + PG8_SA(b, h) + aoff + m * 2048 + k * 1024); } while (0)
#define PG8_LDB(dst, b, h) do { _Pragma("unroll") for (int n = 0; n < 2; ++n) _Pragma("unroll") for (int k = 0; k < 2; ++k) dst[n][k] = *(const PG8_LAS bf16x8*)(lds + PG8_SB(b, h) + boff + n * 2048 + k * 1024); } while (0)
#define PG8_MMA(ai, bj, At, Bt) do { __builtin_amdgcn_s_setprio(1); _Pragma("unroll") for (int m = 0; m < 4; ++m) _Pragma("unroll") for (int n = 0; n < 2; ++n) _Pragma("unroll") for (int k = 0; k < 2; ++k) \
        acc[ai][bj][m][n] = __builtin_amdgcn_mfma_f32_16x16x32_bf16(Bt[n][k], At[m][k], acc[ai][bj][m][n], 0, 0, 0); __builtin_amdgcn_s_setprio(0); } while (0)
#define PG8_WAIT_V(n) asm volatile("s_waitcnt vmcnt(" #n ")" ::: "memory")
#define PG8_WAIT_L(n) asm volatile("s_waitcnt lgkmcnt(" #n ")" ::: "memory")
#define PG8_BAR __builtin_amdgcn_s_barrier()
#define PG8_SCHED __builtin_amdgcn_sched_barrier(0)
    Unit cur, nxt; int ui = 0;
    if (!S.next(0, cur)) return;
    f32x4 acc[2][2][4][2];
#pragma unroll
    for (int a = 0; a < 2; ++a)
#pragma unroll
        for (int b = 0; b < 2; ++b)
#pragma unroll
            for (int m = 0; m < 4; ++m)
#pragma unroll
                for (int n = 0; n < 2; ++n) acc[a][b][m][n] = (f32x4){0.f, 0.f, 0.f, 0.f};
    bf16x8 At[4][2], B0[2][2], B1[2][2];
    const char* cA = (const char*)g.A + (size_t)cur.pm * tstep; const char* cB = (const char*)g.Bt + (size_t)cur.pn * tstep;
    S.a_ready(cur);
    if constexpr (SP2) {
        PG8_STAGE(PG8_SB(0, 0), cB, voffB); PG8_STAGE(PG8_SB(0, 1), cB + hstep, voffB); PG8_STAGE(PG8_SA(0, 0), cA, voffA); PG8_STAGE(PG8_SA(0, 1), cA + hstep, voffA);
        if (wr == 1) PG8_BAR;
        PG8_WAIT_V(2); PG8_BAR;
        PG8_STAGE(PG8_SB(1, 0), cB + kstep, voffB); PG8_STAGE(PG8_SA(1, 0), cA + kstep, voffA); PG8_STAGE(PG8_SB(1, 1), cB + hstep + kstep, voffB);
        PG8_WAIT_V(6); PG8_BAR;
    } else {
        PG8_STAGE(PG8_SB(0, 0), cB, voffB); PG8_STAGE(PG8_SA(0, 0), cA, voffA); PG8_STAGE(PG8_SB(0, 1), cB + hstep, voffB); PG8_STAGE(PG8_SA(0, 1), cA + hstep, voffA);
        if (wr == 1) PG8_BAR;
        PG8_WAIT_V(4); PG8_BAR;
        PG8_STAGE(PG8_SB(1, 0), cB + kstep, voffB); PG8_STAGE(PG8_SA(1, 0), cA + kstep, voffA); PG8_STAGE(PG8_SB(1, 1), cB + hstep + kstep, voffB);
        PG8_WAIT_V(6); PG8_BAR;
    }
    for (;;) {
        const bool has_next = S.next(ui + 1, nxt);
        const char* nA = has_next ? (const char*)g.A + (size_t)nxt.pm * tstep : cA; const char* nB = has_next ? (const char*)g.Bt + (size_t)nxt.pn * tstep : cB;
        for (int t = 0; t < nt; t += 2) {
            const bool last = (t == nt - 2);
            const char* a1 = cA + (size_t)(t + 1) * kstep;
            const char* a2 = last ? nA : cA + (size_t)(t + 2) * kstep; const char* b2 = last ? nB : cB + (size_t)(t + 2) * kstep;
            const char* a3 = a2 + kstep; const char* b3 = b2 + kstep;
            if (last && has_next) S.a_ready(nxt);
            if constexpr (SP2) {
            PG8_LDB(B0, 0, 0); PG8_LDB(B1, 0, 1); PG8_SCHED; PG8_LDA(At, 0, 0); PG8_STAGE(PG8_SA(1, 1), a1 + hstep, voffA);
            PG8_WAIT_V(8); PG8_WAIT_L(0); PG8_BAR; PG8_MMA(0, 0, At, B0); PG8_MMA(0, 1, At, B1); PG8_BAR; PG8_SCHED;
            PG8_LDA(At, 0, 1); PG8_STAGE(PG8_SB(0, 0), b2, voffB); PG8_STAGE(PG8_SB(0, 1), b2 + hstep, voffB); PG8_STAGE(PG8_SA(0, 0), a2, voffA);
            PG8_WAIT_V(8); PG8_WAIT_L(0); PG8_BAR; PG8_MMA(1, 0, At, B0); PG8_MMA(1, 1, At, B1); PG8_BAR; PG8_SCHED;
            PG8_LDB(B0, 1, 0); PG8_LDB(B1, 1, 1); PG8_SCHED; PG8_LDA(At, 1, 0); PG8_STAGE(PG8_SA(0, 1), a2 + hstep, voffA);
            PG8_WAIT_V(8); PG8_WAIT_L(0); PG8_BAR; PG8_MMA(0, 0, At, B0); PG8_MMA(0, 1, At, B1); PG8_BAR; PG8_SCHED;
            PG8_LDA(At, 1, 1); PG8_STAGE(PG8_SB(1, 0), b3, voffB); PG8_STAGE(PG8_SB(1, 1), b3 + hstep, voffB); PG8_STAGE(PG8_SA(1, 0), a3, voffA);
            PG8_WAIT_V(8); PG8_WAIT_L(0); PG8_BAR; PG8_MMA(1, 0, At, B0); PG8_MMA(1, 1, At, B1); PG8_BAR; PG8_SCHED;
            } else {
            PG8_LDB(B0, 0, 0); PG8_SCHED; PG8_LDA(At, 0, 0); PG8_STAGE(PG8_SA(1, 1), a1 + hstep, voffA);
            PG8_WAIT_L(8); PG8_BAR; PG8_WAIT_L(0); PG8_MMA(0, 0, At, B0); PG8_BAR; PG8_SCHED;
            PG8_LDB(B1, 0, 1); PG8_STAGE(PG8_SB(0, 0), b2, voffB);
            PG8_BAR; PG8_WAIT_L(0); PG8_MMA(0, 1, At, B1); PG8_BAR;
            PG8_LDA(At, 0, 1); PG8_STAGE(PG8_SA(0, 0), a2, voffA);
            PG8_BAR; PG8_WAIT_L(0); PG8_MMA(1, 0, At, B0); PG8_BAR; PG8_SCHED;
            PG8_STAGE(PG8_SB(0, 1), b2 + hstep, voffB);
            PG8_WAIT_V(6); PG8_BAR; PG8_MMA(1, 1, At, B1); PG8_BAR;
            PG8_LDB(B0, 1, 0); PG8_SCHED; PG8_LDA(At, 1, 0); PG8_STAGE(PG8_SA(0, 1), a2 + hstep, voffA);
            PG8_WAIT_L(8); PG8_BAR; PG8_WAIT_L(0); PG8_MMA(0, 0, At, B0); PG8_BAR; PG8_SCHED;
            PG8_LDB(B1, 1, 1); PG8_STAGE(PG8_SB(1, 0), b3, voffB);
            PG8_BAR; PG8_WAIT_L(0); PG8_MMA(0, 1, At, B1); PG8_BAR;
            PG8_LDA(At, 1, 1); PG8_STAGE(PG8_SA(1, 0), a3, voffA);
            PG8_BAR; PG8_WAIT_L(0); PG8_MMA(1, 0, At, B0); PG8_BAR; PG8_SCHED;
            PG8_STAGE(PG8_SB(1, 1), b3 + hstep, voffB);
            PG8_WAIT_V(6); PG8_BAR; PG8_MMA(1, 1, At, B1); PG8_BAR;
            }
        }
        if constexpr (ALIGN_EPI) { if (wr == 0) PG8_BAR; }
        if constexpr (!Epi::AFTER_DRAIN) { E(acc, cur, wr, wc, fr, fq); S.done(cur); }
        if (!has_next) break;
#pragma unroll
        for (int a = 0; a < 2; ++a)
#pragma unroll
            for (int b = 0; b < 2; ++b)
#pragma unroll
                for (int m = 0; m < 4; ++m)
#pragma unroll
                    for (int n = 0; n < 2; ++n) acc[a][b][m][n] = (f32x4){0.f, 0.f, 0.f, 0.f};
        cur = nxt; cA = nA; cB = nB; ++ui;
        if constexpr (ALIGN_EPI) { if (wr == 1) PG8_BAR; }
    }
    PG8_WAIT_V(0);
    if constexpr (!ALIGN_EPI) { if (wr == 0) PG8_BAR; }
    PG8_BAR;
    if constexpr (Epi::AFTER_DRAIN) { E.fused(acc, cur, wr, wc, fr, fq, lds, wid, lane); S.done(cur); }
#undef PG8_SA
#undef PG8_SB
#undef PG8_STAGE
#undef PG8_LDA
#undef PG8_LDB
#undef PG8_MMA
#undef PG8_WAIT_V
#undef PG8_WAIT_L
#undef PG8_BAR
#undef PG8_SCHED
}
}

#ifndef MK_N_LAUNCHES
#define MK_N_LAUNCHES 1
#endif
constexpr int N_LAUNCHES = MK_N_LAUNCHES;
constexpr int N_PHASES = 8;

constexpr int NWAVES = 8;
constexpr int BATCH = 16, SEQ = 2048, DM = 1024, M = BATCH * SEQ;
constexpr int DIN = 3524, NPROJ = 3584;
constexpr float EPS = 1e-6f;
constexpr float C2 = 0.125f * 1.4426950408889634f;

constexpr size_t MiB = 1u << 20;
constexpr size_t WS_CTL = 0, CTL_ZERO_BYTES = 1 * MiB;
constexpr size_t WS_WIN = 2 * MiB;
constexpr size_t WS_WOUT = 10 * MiB;
constexpr size_t WS_CS = 12 * MiB;
constexpr size_t WS_SSA = 14 * MiB;
constexpr size_t WS_XN = 16 * MiB;
constexpr size_t WS_Y = WS_XN;
constexpr size_t WS_QA = 80 * MiB;
constexpr size_t WS_KA = WS_QA + 32 * MiB, WS_VA = WS_QA + 64 * MiB, WS_ZA = WS_QA + 96 * MiB, WS_QB = WS_QA + 128 * MiB, WS_ZB = WS_QA + 160 * MiB;
constexpr size_t WS_IQ = 272 * MiB;
constexpr size_t WS_MISC = 288 * MiB;
constexpr size_t WS_KB = 320 * MiB;
constexpr size_t WS_VB = 324 * MiB;
constexpr size_t WS_IKN = 356 * MiB;
constexpr size_t WS_IW = 364 * MiB;
constexpr size_t WS_MASK = 366 * MiB;
constexpr size_t WS_END = 376 * MiB;
constexpr int CW_BAR = 4096;

constexpr int LDS_BYTES = 155648;
constexpr int LDSCTL_OFF = LDS_BYTES - 256;

#define GAS __attribute__((address_space(1)))
#define LAS __attribute__((address_space(3)))
typedef unsigned short bf16;
typedef unsigned v4u __attribute__((ext_vector_type(4)));
typedef float f32x4 __attribute__((ext_vector_type(4)));
typedef GAS unsigned gu32;
#define RLX_AGENT __ATOMIC_RELAXED, __HIP_MEMORY_SCOPE_AGENT
__device__ __forceinline__ unsigned f2bf(float f) { unsigned u = __builtin_bit_cast(unsigned, f); return (u + 0x7fffu + ((u >> 16) & 1u)) >> 16; }
__device__ __forceinline__ unsigned pk2(float lo, float hi) { return f2bf(lo) | (f2bf(hi) << 16); }
__device__ __forceinline__ float bf2f(unsigned short h) { return __builtin_bit_cast(float, (unsigned)h << 16); }
__device__ __forceinline__ float bflo(unsigned w) { return __builtin_bit_cast(float, w << 16); }
__device__ __forceinline__ float bfhi(unsigned w) { return __builtin_bit_cast(float, w & 0xffff0000u); }
__device__ __forceinline__ float wave_sum(float v) {
#pragma unroll
    for (int o = 1; o < 64; o <<= 1) v += __shfl_xor(v, o);
    return v;
}
__device__ __forceinline__ float wave_max(float v) {
#pragma unroll
    for (int o = 1; o < 64; o <<= 1) v = fmaxf(v, __shfl_xor(v, o));
    return v;
}

#define XB_TMO      128
#define XB_XCNT(j)  (256  + 64 * (j))
#define XB_XSUB(j)  (1280 + 64 * (j))
#define XB_XGEN(j)  (2304 + 64 * (j))
#define XB_TOP      3328
#define XB_TOPGEN   3392
#define XCD_BAR_WORDS 3456
#define XB_SPIN_CAP (1u << 18)

__device__ __forceinline__ unsigned xb_ld(unsigned* p)              { return __hip_atomic_load(p, __ATOMIC_RELAXED, __HIP_MEMORY_SCOPE_AGENT); }
__device__ __forceinline__ unsigned xb_add(unsigned* p, unsigned v) { return __hip_atomic_fetch_add(p, v, __ATOMIC_RELAXED, __HIP_MEMORY_SCOPE_AGENT); }
__device__ __forceinline__ unsigned xb_xcc_id() { return (unsigned)__builtin_amdgcn_s_getreg((3 << 11) | 20) & 0xFu; }
#define XB_SPIN(cond, bar) do { unsigned _sp = 0; while (cond) { __builtin_amdgcn_s_sleep(1); \
    if ((++_sp & 255u) == 0u) { if (xb_ld(&(bar)[XB_TMO])) break; if (_sp > XB_SPIN_CAP) { atomicAdd(&(bar)[XB_TMO], 1u); break; } } } } while (0)

struct XcdBarrier {
    unsigned* bar; unsigned x;
    volatile LAS unsigned* st;
};

__device__ __forceinline__ XcdBarrier xcd_barrier_post(unsigned* bar, volatile LAS unsigned* st) {
    XcdBarrier b; b.bar = bar; b.x = xb_xcc_id(); b.st = st;
    if (threadIdx.x == 0) (void)xb_add(&bar[XB_XCNT(b.x)], 1u);
    return b;
}
__device__ __forceinline__ void xcd_barrier_complete(unsigned* bar, unsigned x, unsigned& nloc, unsigned& nx) {
    const unsigned G = gridDim.x * gridDim.y * gridDim.z;
    unsigned sum, cnt, mine, sp = 0u;
    for (;;) {
        sum = 0u; cnt = 0u; mine = 0u;
#pragma unroll
        for (unsigned j = 0; j < 16; ++j) { const unsigned c = xb_ld(&bar[XB_XCNT(j)]); sum += c; cnt += (c > 0u) ? 1u : 0u; mine = (j == x) ? c : mine; }
        if (sum == G) break;
        __builtin_amdgcn_s_sleep(1);
        if ((++sp & 255u) == 0u) { if (xb_ld(&bar[XB_TMO])) break; if (sp > XB_SPIN_CAP) { atomicAdd(&bar[XB_TMO], 1u); break; } }
    }
    nloc = mine > 0u ? mine : 1u; nx = cnt > 0u ? cnt : 1u;
}

__device__ __forceinline__ void xcd_barrier(const XcdBarrier& b) {
    asm volatile("s_waitcnt vmcnt(0)" ::: "memory");
    __syncthreads();
    if (threadIdx.x == 0) {
        unsigned* bar = b.bar;
        __builtin_amdgcn_s_waitcnt(0);
        unsigned nloc = b.st[0], nx = b.st[1];
        if (nloc == 0u) { xcd_barrier_complete(bar, b.x, nloc, nx); b.st[0] = nloc; b.st[1] = nx; }
        const unsigned old = xb_add(&bar[XB_XSUB(b.x)], 1u);
        const unsigned gen = old / nloc;
        if (old + 1u == (gen + 1u) * nloc) {
            __builtin_amdgcn_fence(__ATOMIC_RELEASE, "agent");
            asm volatile("s_waitcnt vmcnt(0)" ::: "memory");
            const unsigned og = xb_add(&bar[XB_TOP], 1u);
            const unsigned tg = og / nx;
            if (og + 1u == (tg + 1u) * nx) xb_add(&bar[XB_TOPGEN], 1u);
            else XB_SPIN(xb_ld(&bar[XB_TOPGEN]) == tg, bar);
            __builtin_amdgcn_fence(__ATOMIC_ACQUIRE, "agent");
            xb_add(&bar[XB_XGEN(b.x)], 1u);
            asm volatile("s_waitcnt vmcnt(0)" ::: "memory");
        } else {
            XB_SPIN(xb_ld(&bar[XB_XGEN(b.x)]) == gen, bar);
            __builtin_amdgcn_fence(__ATOMIC_ACQUIRE, "agent");
            asm volatile("s_waitcnt vmcnt(0)" ::: "memory");
        }
    }
    __syncthreads();
}


struct Ctx {
    const float* x; const int* pos; const float* g_in; const float* w_in; const float* g_kv; const float* w_uk; const float* w_uv; const float* g_ik;
    const float* g_a; const float* g_b; const float* w_out; const float* g_fin;
    float* out; unsigned char* ws;
    int tid, lane, wave, G, gw, NGW;
};

namespace pg8 {
__device__ __forceinline__ unsigned cvt_pk_bf16(float lo, float hi) { unsigned r; asm volatile("v_cvt_pk_bf16_f32 %0, %1, %2" : "=v"(r) : "v"(lo), "v"(hi)); return r; }
struct EpiProj {
    static constexpr bool PERM = true, AFTER_DRAIN = false;
    unsigned char* ws; const float* cs;
    __device__ __forceinline__ void operator()(const f32x4 (&acc)[2][2][4][2], const Unit& u, int wr, int wc, int fr, int fq) const {
        const int pn = u.pn;
        const int row0 = u.pm * BM + wr * 64 + fr;
        if (pn == 13) {
            float* base = (float*)(ws + WS_MISC) + wc * 32 + 8 * fq;
#pragma unroll
            for (int ai = 0; ai < 2; ++ai)
#pragma unroll
                for (int m = 0; m < 4; ++m) { float* rowp = base + (size_t)(row0 + ai * HALF + m * 16) * 256;
#pragma unroll
                    for (int bj = 0; bj < 2; ++bj) { *(f32x4*)(rowp + bj * HALF) = acc[ai][bj][m][0]; *(f32x4*)(rowp + bj * HALF + 4) = acc[ai][bj][m][1]; } }
            return;
        }
        bf16_t* base; int ld;
        if (pn == 12) { base = (bf16_t*)(ws + WS_IQ); ld = 256; }
        else { base = (bf16_t*)(ws + WS_QA + (size_t)(pn >> 1) * (32 * MiB)) + (pn & 1) * 256; ld = 512; }
        const bool rope = (pn < 4) || (pn == 8) || (pn == 9) || (pn == 12);
        const float sc = (pn < 2 || pn == 8 || pn == 9) ? C2 : 1.0f;
        const bool ropew = rope && ((wc & 1) == 0);
        base += wc * 32 + 8 * fq;
#pragma unroll
        for (int ai = 0; ai < 2; ++ai)
#pragma unroll
            for (int m = 0; m < 4; ++m) {
                const int row = row0 + ai * HALF + m * 16;
                bf16_t* rowp = base + (size_t)row * ld;
                f32x4 c0 = {1.f, 1.f, 1.f, 1.f}, c1 = c0, s0 = {0.f, 0.f, 0.f, 0.f}, s1 = s0;
                if (ropew) { const f32x4* cp = (const f32x4*)(cs + (size_t)row * 16); c0 = cp[0]; c1 = cp[1]; s0 = cp[2]; s1 = cp[3]; if (fq == 0) { s0 = -s0; s1 = -s1; } if (fq >= 2) { c0 = (f32x4){1.f, 1.f, 1.f, 1.f}; c1 = c0; s0 = (f32x4){0.f, 0.f, 0.f, 0.f}; s1 = s0; } }
#pragma unroll
                for (int bj = 0; bj < 2; ++bj) {
                    f32x4 v0 = acc[ai][bj][m][0], v1 = acc[ai][bj][m][1];
                    if (ropew) {
                        f32x4 p0, p1;
#pragma unroll
                        for (int e = 0; e < 4; ++e) { p0[e] = __shfl_xor(v0[e], 16); p1[e] = __shfl_xor(v1[e], 16); }
                        v0 = v0 * c0 + p0 * s0; v1 = v1 * c1 + p1 * s1;
                    }
                    v0 = v0 * sc; v1 = v1 * sc;
                    u32x4 w; w.x = cvt_pk_bf16(v0[0], v0[1]); w.y = cvt_pk_bf16(v0[2], v0[3]); w.z = cvt_pk_bf16(v1[0], v1[1]); w.w = cvt_pk_bf16(v1[2], v1[3]);
                    *(u32x4*)(rowp + bj * HALF) = w;
                }
            }
    }
};
struct EpiOut {
    static constexpr bool PERM = false, AFTER_DRAIN = false;
    const float* x; float* out; const float* ssa;
    __device__ __forceinline__ void operator()(const f32x4 (&acc)[2][2][4][2], const Unit& u, int wr, int wc, int fr, int fq) const {
        const int col0 = u.pn * BM + wc * 32 + 4 * fq;
#pragma unroll
        for (int ai = 0; ai < 2; ++ai)
#pragma unroll
            for (int m = 0; m < 4; ++m) {
                const int r = u.pm * BM + ai * HALF + wr * 64 + m * 16 + fr;
                const f32x4 a0 = *(const f32x4*)(ssa + (size_t)r * 8), a1 = *(const f32x4*)(ssa + (size_t)r * 8 + 4);
                const float ss = ((a0[0] + a0[1]) + (a0[2] + a0[3])) + ((a1[0] + a1[1]) + (a1[2] + a1[3]));
                const float rs = 1.0f / sqrtf(ss * (1.0f / 512.0f) + EPS);
                const size_t off = (size_t)r * DM + col0;
#pragma unroll
                for (int bj = 0; bj < 2; ++bj)
#pragma unroll
                    for (int n = 0; n < 2; ++n) { const f32x4 xv = *(const f32x4*)(x + off + bj * HALF + n * 16); *(f32x4*)(out + off + bj * HALF + n * 16) = xv + acc[ai][bj][m][n] * rs; }
            }
    }
};
}

__device__ __forceinline__ void p0_transpose_item(const float* W, int ldw, int srccol0, int nvalid, const float* rowgain, bf16* WT, int K, int n0, int k0, LAS float* scr, int lane) {
#pragma unroll 8
    for (int i = 0; i < 32; ++i) { const int kk = 2 * i + (lane >> 5), n = lane & 31; float v = 0.f; if (n < nvalid) { v = W[(size_t)(k0 + kk) * ldw + srccol0 + n]; if (rowgain) v *= rowgain[k0 + kk]; } scr[kk * 33 + n] = v; }
    asm volatile("s_waitcnt lgkmcnt(0)" ::: "memory");
    const int c = lane & 7;
#pragma unroll
    for (int j = 0; j < 4; ++j) { const int n = (lane >> 3) + 8 * j; const LAS float* s = scr + (8 * c) * 33 + n;
        v4u o; o.x = pk2(s[0 * 33], s[1 * 33]); o.y = pk2(s[2 * 33], s[3 * 33]); o.z = pk2(s[4 * 33], s[5 * 33]); o.w = pk2(s[6 * 33], s[7 * 33]);
        *(GAS v4u*)(WT + (size_t)(n0 + n) * K + k0 + 8 * c) = o; }
    asm volatile("s_waitcnt lgkmcnt(0)" ::: "memory");
}
__device__ __forceinline__ void p0_prologue(const Ctx& C, LAS unsigned char* lds) {
    LAS float* scr = (LAS float*)(lds + C.wave * 16384);
    constexpr int I1 = 16 * (NPROJ / 32), I2 = 16 * (DM / 32);
    for (int it = C.gw; it < I1 + I2; it += C.NGW) {
        if (it < I1) {
            const int kb = it / (NPROJ / 32), nb = it % (NPROJ / 32), n0 = 32 * nb;
            int src;
            if (n0 < 2560) src = n0; else if (n0 < 3072) src = 2688 + (n0 - 2560); else if (n0 < 3328) src = 3200 + (n0 - 3072); else if (n0 < 3456) src = 2560 + (n0 - 3328); else src = n0;
            const int nvalid = (n0 + 32 <= DIN) ? 32 : (n0 < DIN ? DIN - n0 : 0);
            p0_transpose_item(C.w_in, DIN, src, nvalid, nullptr, (bf16*)(C.ws + WS_WIN), DM, n0, 64 * kb, scr, C.lane);
        } else {
            const int r = it - I1, kb = r / (DM / 32), nb = r % (DM / 32);
            const float* gain = (kb < 8) ? C.g_a : (C.g_b - 512);
            p0_transpose_item(C.w_out, DM, 32 * nb, 32, gain, (bf16*)(C.ws + WS_WOUT), DM, 32 * nb, 64 * kb, scr, C.lane);
        }
    }
    for (int m = C.gw; m < M; m += C.NGW) {
        const GAS f32x4* xr = (const GAS f32x4*)(C.x + (size_t)m * DM) + C.lane;
        const GAS f32x4* gr = (const GAS f32x4*)C.g_in + C.lane;
        f32x4 v[4]; float s = 0.f;
#pragma unroll
        for (int j = 0; j < 4; ++j) { v[j] = xr[64 * j]; s += (v[j].x * v[j].x + v[j].y * v[j].y) + (v[j].z * v[j].z + v[j].w * v[j].w); }
        const float rs = 1.0f / sqrtf(wave_sum(s) * (1.0f / DM) + EPS);
        GAS unsigned long long* o8 = (GAS unsigned long long*)((bf16*)(C.ws + WS_XN) + (size_t)m * DM) + C.lane;
#pragma unroll
        for (int j = 0; j < 4; ++j) { const f32x4 g = gr[64 * j]; o8[64 * j] = (unsigned long long)pk2(v[j].x * rs * g.x, v[j].y * rs * g.y) | ((unsigned long long)pk2(v[j].z * rs * g.z, v[j].w * rs * g.w) << 32); }
    }
    for (int e = blockIdx.x * (NWAVES * 64) + C.tid; e < M * 8; e += C.G * NWAVES * 64) {
        const int tok = e >> 3, j = e & 7;
        const float inv = exp2f(-(float)j * (18.931568569324174f / 8.0f));
        const float ang = (float)C.pos[tok] * inv;
        const double rev = (double)ang * 0.15915494309189535;
        const float fr = (float)(rev - rint(rev));
        float* cs = (float*)(C.ws + WS_CS) + (size_t)tok * 16;
        cs[j] = __builtin_amdgcn_cosf(fr); cs[8 + j] = __builtin_amdgcn_sinf(fr);
    }
}

__device__ __forceinline__ void p2_token_local(const Ctx& C, LAS unsigned char* lds) {
    LAS float* ck = (LAS float*)(lds + C.wave * 16384);
    const int lane = C.lane;
    const float* misc = (const float*)(C.ws + WS_MISC);
    const float* cs = (const float*)(C.ws + WS_CS);
    for (int grp = C.gw; grp < M / 8; grp += C.NGW) {
        const int tok0 = grp * 8;
#pragma unroll 1
        for (int tt = 0; tt < 8; ++tt) {
            const int tok = tok0 + tt; const float* mr = misc + (size_t)tok * 256;
            const float a = mr[2 * lane], b = mr[2 * lane + 1];
            const float rs = 1.0f / sqrtf(wave_sum(a * a + b * b) * (1.0f / 128.0f) + EPS);
            ck[tt * 128 + 2 * lane] = a * rs * C.g_kv[2 * lane]; ck[tt * 128 + 2 * lane + 1] = b * rs * C.g_kv[2 * lane + 1];
            const float k = mr[128 + lane];
            const float rk = 1.0f / sqrtf(wave_sum(k * k) * (1.0f / 64.0f) + EPS);
            float kn = k * rk * C.g_ik[lane];
            const float partner = __shfl_xor(kn, 8);
            if (lane < 16) { const float c = cs[(size_t)tok * 16 + (lane & 7)], s = cs[(size_t)tok * 16 + 8 + (lane & 7)]; kn = (lane < 8) ? kn * c - partner * s : kn * c + partner * s; }
            ((bf16*)(C.ws + WS_IKN))[(size_t)tok * 64 + lane] = (bf16)f2bf(kn);
            if (lane < 4) ((float*)(C.ws + WS_IW))[(size_t)tok * 4 + lane] = mr[192 + lane] * 0.0625f;
        }
        asm volatile("s_waitcnt lgkmcnt(0)" ::: "memory");
        float acc[9][8];
#pragma unroll
        for (int i = 0; i < 9; ++i)
#pragma unroll
            for (int t = 0; t < 8; ++t) acc[i][t] = 0.f;
#pragma unroll 2
        for (int c = 0; c < 128; ++c) {
            float w[9]; w[0] = C.w_uk[c * 64 + lane];
#pragma unroll
            for (int h = 0; h < 8; ++h) w[1 + h] = C.w_uv[(size_t)(h * 128 + c) * 64 + lane];
#pragma unroll
            for (int t = 0; t < 8; ++t) { const float a = ck[t * 128 + c];
#pragma unroll
                for (int i = 0; i < 9; ++i) acc[i][t] += a * w[i]; }
        }
#pragma unroll
        for (int t = 0; t < 8; ++t) {
            const int tok = tok0 + t;
            float kb = acc[0][t];
            const float partner = __shfl_xor(kb, 8);
            if (lane < 16) { const float c = cs[(size_t)tok * 16 + (lane & 7)], s = cs[(size_t)tok * 16 + 8 + (lane & 7)]; kb = (lane < 8) ? kb * c - partner * s : kb * c + partner * s; }
            ((bf16*)(C.ws + WS_KB))[(size_t)tok * 64 + lane] = (bf16)f2bf(kb);
#pragma unroll
            for (int h = 0; h < 8; ++h) ((bf16*)(C.ws + WS_VB))[(size_t)tok * 512 + h * 64 + lane] = (bf16)f2bf(acc[1 + h][t]);
        }
        asm volatile("s_waitcnt lgkmcnt(0)" ::: "memory");
    }
}

__device__ __forceinline__ void select_topk(const LAS float* srow, int t, unsigned long long* maskrow, int lane) {
    unsigned key[32];
#pragma unroll
    for (int j = 0; j < 32; ++j) { const int s = 64 * j + lane; unsigned u = 0u; if (s <= t) { const unsigned f = __float_as_uint(srow[s]); u = (f & 0x80000000u) ? ~f : (f | 0x80000000u); } key[j] = u; }
    const int nregs = (t >> 6) + 1;
    unsigned long long myword = 0ull;
    if (t + 1 <= 256) {
#pragma unroll
        for (int j = 0; j < 32; ++j) { const unsigned long long b = __builtin_amdgcn_ballot_w64(key[j] != 0u); if (lane == j) myword = b; }
    } else {
        unsigned T = 0u; bool exact = false;
        for (int bit = 31; bit >= 0; --bit) {
            const unsigned cand = T | (1u << bit);
            int c = 0;
#pragma unroll
            for (int j = 0; j < 32; ++j) if (j < nregs) c += __builtin_popcountll(__builtin_amdgcn_ballot_w64(key[j] >= cand));
            if (c >= 256) { T = cand; if (c == 256) { exact = true; break; } }
        }
        if (exact) {
#pragma unroll
            for (int j = 0; j < 32; ++j) { const unsigned long long b = __builtin_amdgcn_ballot_w64(key[j] >= T); if (lane == j) myword = b; }
        } else {
            int cgt = 0;
#pragma unroll
            for (int j = 0; j < 32; ++j) cgt += __builtin_popcountll(__builtin_amdgcn_ballot_w64(key[j] > T));
            const int r = 256 - cgt; int running = 0;
            const unsigned long long ltmask = (1ull << lane) - 1ull;
#pragma unroll
            for (int j = 0; j < 32; ++j) {
                const unsigned long long eq = __builtin_amdgcn_ballot_w64(key[j] == T);
                const int pre = running + __builtin_popcountll(eq & ltmask);
                const bool s = (key[j] > T) || (key[j] == T && pre < r);
                const unsigned long long b = __builtin_amdgcn_ballot_w64(s);
                if (lane == j) myword = b;
                running += __builtin_popcountll(eq);
            }
        }
    }
    if (lane < 32) maskrow[lane] = myword;
}
__device__ __forceinline__ void p3_indexer(const Ctx& C, LAS unsigned char* lds) {
    LAS float* scores = (LAS float*)lds;
    LAS float* iql = (LAS float*)(lds + 131072);
    LAS float* iwl = (LAS float*)(lds + 131072 + 16384);
    const bf16* IQ = (const bf16*)(C.ws + WS_IQ); const bf16* IKN = (const bf16*)(C.ws + WS_IKN); const float* IW = (const float*)(C.ws + WS_IW);
    unsigned long long* MASK = (unsigned long long*)(C.ws + WS_MASK);
    for (int unit = blockIdx.x; unit < BATCH * (SEQ / 16); unit += C.G) {
        const int b = unit / (SEQ / 16), t0 = (unit % (SEQ / 16)) * 16; const size_t tokb = (size_t)b * SEQ;
        {
            const int idx = C.tid * 8; const v4u w = *(const GAS v4u*)(IQ + (tokb + t0 + (idx >> 8)) * 256 + (idx & 255));
            LAS float* d = iql + idx; d[0] = bflo(w.x); d[1] = bfhi(w.x); d[2] = bflo(w.y); d[3] = bfhi(w.y); d[4] = bflo(w.z); d[5] = bfhi(w.z); d[6] = bflo(w.w); d[7] = bfhi(w.w);
            if (C.tid < 64) iwl[C.tid] = IW[(tokb + t0) * 4 + C.tid];
        }
        __syncthreads();
        const int nkeys = t0 + 16;
        for (int s = C.tid; s < nkeys; s += NWAVES * 64) {
            float k[64];
            const GAS v4u* kp = (const GAS v4u*)(IKN + (tokb + s) * 64);
#pragma unroll
            for (int i = 0; i < 8; ++i) { const v4u w = kp[i]; k[8 * i] = bflo(w.x); k[8 * i + 1] = bfhi(w.x); k[8 * i + 2] = bflo(w.y); k[8 * i + 3] = bfhi(w.y); k[8 * i + 4] = bflo(w.z); k[8 * i + 5] = bfhi(w.z); k[8 * i + 6] = bflo(w.w); k[8 * i + 7] = bfhi(w.w); }
#pragma unroll 1
            for (int q = 0; q < 16; ++q) {
                float sc = 0.f;
#pragma unroll
                for (int h = 0; h < 4; ++h) {
                    const LAS f32x4* qp = (const LAS f32x4*)(iql + q * 256 + h * 64);
                    float d0 = 0.f, d1 = 0.f;
#pragma unroll
                    for (int i = 0; i < 16; ++i) { const f32x4 qv = qp[i]; d0 += qv.x * k[4 * i] + qv.z * k[4 * i + 2]; d1 += qv.y * k[4 * i + 1] + qv.w * k[4 * i + 3]; }
                    sc += iwl[q * 4 + h] * fmaxf(d0 + d1, 0.f);
                }
                scores[q * 2048 + s] = sc;
            }
        }
        __syncthreads();
#pragma unroll 1
        for (int qq = 0; qq < 2; ++qq) { const int q = C.wave * 2 + qq, t = t0 + q; select_topk(scores + q * 2048, t, MASK + (tokb + t) * 32, C.lane); }
        __syncthreads();
    }
}

__device__ __forceinline__ void p4_mixer_a(const Ctx& C) {
    const bf16* QA = (const bf16*)(C.ws + WS_QA); const bf16* KA = (const bf16*)(C.ws + WS_KA); const bf16* VA = (const bf16*)(C.ws + WS_VA); const bf16* ZA = (const bf16*)(C.ws + WS_ZA);
    bf16* Y = (bf16*)(C.ws + WS_Y); float* SSA = (float*)(C.ws + WS_SSA);
    const int lane = C.lane;
    for (int job = C.gw; job < M * 8; job += C.NGW) {
        const int tok = job >> 3, h = job & 7, b = tok / SEQ, t = tok % SEQ; const size_t tokb = (size_t)b * SEQ;
        float qf[64];
        { const GAS v4u* qp = (const GAS v4u*)(QA + (size_t)tok * 512 + h * 64);
#pragma unroll
          for (int i = 0; i < 8; ++i) { const v4u w = qp[i]; qf[8 * i] = bflo(w.x); qf[8 * i + 1] = bfhi(w.x); qf[8 * i + 2] = bflo(w.y); qf[8 * i + 3] = bfhi(w.y); qf[8 * i + 4] = bflo(w.z); qf[8 * i + 5] = bfhi(w.z); qf[8 * i + 6] = bflo(w.w); qf[8 * i + 7] = bfhi(w.w); } }
        float sv[7]; int pv[7]; float mx = -INFINITY;
#pragma unroll
        for (int i = 0; i < 7; ++i) {
            const int e = lane + 64 * i; int d, j;
            if (e < 129) { d = 1; j = e; } else if (e < 258) { d = 4; j = e - 129; } else { d = 16; j = e - 258; }
            const int p = t - j * d; const bool valid = (e < 387) && (p >= 0);
            float s = -INFINITY;
            if (valid) { const GAS v4u* kp = (const GAS v4u*)(KA + (tokb + p) * 512 + h * 64); float a0 = 0.f, a1 = 0.f;
#pragma unroll
                for (int c = 0; c < 8; ++c) { const v4u w = kp[c]; a0 += qf[8 * c] * bflo(w.x) + qf[8 * c + 2] * bflo(w.y) + qf[8 * c + 4] * bflo(w.z) + qf[8 * c + 6] * bflo(w.w); a1 += qf[8 * c + 1] * bfhi(w.x) + qf[8 * c + 3] * bfhi(w.y) + qf[8 * c + 5] * bfhi(w.z) + qf[8 * c + 7] * bfhi(w.w); }
                s = a0 + a1; }
            sv[i] = s; pv[i] = valid ? p : 0; mx = fmaxf(mx, s);
        }
        mx = wave_max(mx);
        float lsum = 0.f;
#pragma unroll
        for (int i = 0; i < 7; ++i) { sv[i] = exp2f(sv[i] - mx); lsum += sv[i]; }
        lsum = wave_sum(lsum);
        float o = 0.f;
        const bf16* vcol = VA + tokb * 512 + h * 64 + lane;
#pragma unroll
        for (int i = 0; i < 7; ++i) {
            const int cnt = (i < 6) ? 64 : 3;
#pragma unroll 8
            for (int l2 = 0; l2 < cnt; ++l2) { const float pp = __builtin_bit_cast(float, __builtin_amdgcn_readlane(__builtin_bit_cast(int, sv[i]), l2)); const int ps = __builtin_amdgcn_readlane(pv[i], l2);
                o += pp * bf2f(vcol[(size_t)ps * 512]); }
        }
        o = o / lsum;
        const float z = bf2f(ZA[(size_t)tok * 512 + h * 64 + lane]);
        const float v = o * z / (1.0f + __expf(-z));
        const float ss = wave_sum(v * v);
        if (lane == 0) SSA[(size_t)tok * 8 + h] = ss;
        Y[(size_t)tok * DM + h * 64 + lane] = (bf16)f2bf(v);
    }
}

__device__ __forceinline__ void p5_mixer_b(const Ctx& C, LAS unsigned char* lds) {
    const bf16* QB = (const bf16*)(C.ws + WS_QB); const bf16* KB = (const bf16*)(C.ws + WS_KB); const bf16* VB = (const bf16*)(C.ws + WS_VB); const bf16* ZB = (const bf16*)(C.ws + WS_ZB);
    const unsigned long long* MASK = (const unsigned long long*)(C.ws + WS_MASK);
    bf16* Y = (bf16*)(C.ws + WS_Y); const float* SSA = (const float*)(C.ws + WS_SSA);
    LAS float* red = (LAS float*)lds;
    const int lane = C.lane, h = C.wave;
    for (int tok = blockIdx.x; tok < M; tok += C.G) {
        const int b = tok / SEQ, t = tok % SEQ; const size_t tokb = (size_t)b * SEQ;
        float qf[64];
        { const GAS v4u* qp = (const GAS v4u*)(QB + (size_t)tok * 512 + h * 64);
#pragma unroll
          for (int i = 0; i < 8; ++i) { const v4u w = qp[i]; qf[8 * i] = bflo(w.x); qf[8 * i + 1] = bfhi(w.x); qf[8 * i + 2] = bflo(w.y); qf[8 * i + 3] = bfhi(w.y); qf[8 * i + 4] = bflo(w.z); qf[8 * i + 5] = bfhi(w.z); qf[8 * i + 6] = bflo(w.w); qf[8 * i + 7] = bfhi(w.w); } }
        const int nw = (t >> 6) + 1;
        float sv[32]; float mx = -INFINITY;
#pragma unroll
        for (int j = 0; j < 32; ++j) {
            float s = -INFINITY;
            if (j < nw) {
                const unsigned long long w = MASK[(size_t)tok * 32 + j];
                if ((w >> lane) & 1ull) { const GAS v4u* kp = (const GAS v4u*)(KB + (tokb + 64 * j + lane) * 64); float a0 = 0.f, a1 = 0.f;
#pragma unroll
                    for (int c = 0; c < 8; ++c) { const v4u x = kp[c]; a0 += qf[8 * c] * bflo(x.x) + qf[8 * c + 2] * bflo(x.y) + qf[8 * c + 4] * bflo(x.z) + qf[8 * c + 6] * bflo(x.w); a1 += qf[8 * c + 1] * bfhi(x.x) + qf[8 * c + 3] * bfhi(x.y) + qf[8 * c + 5] * bfhi(x.z) + qf[8 * c + 7] * bfhi(x.w); }
                    s = a0 + a1; }
            }
            sv[j] = s; mx = fmaxf(mx, s);
        }
        mx = wave_max(mx);
        float lsum = 0.f;
#pragma unroll
        for (int j = 0; j < 32; ++j) { sv[j] = exp2f(sv[j] - mx); lsum += sv[j]; }
        lsum = wave_sum(lsum);
        float o = 0.f;
        const bf16* vcol = VB + tokb * 512 + h * 64 + lane;
#pragma unroll
        for (int j = 0; j < 32; ++j) {
            if (j < nw) {
                const unsigned long long wv = MASK[(size_t)tok * 32 + j];
                unsigned wlo = __builtin_amdgcn_readfirstlane((unsigned)wv), whi = __builtin_amdgcn_readfirstlane((unsigned)(wv >> 32));
                unsigned long long w = ((unsigned long long)whi << 32) | wlo;
                while (w) { const int l2 = __builtin_ctzll(w); w &= w - 1ull;
                    const float pp = __builtin_bit_cast(float, __builtin_amdgcn_readlane(__builtin_bit_cast(int, sv[j]), l2));
                    o += pp * bf2f(vcol[(size_t)(64 * j + l2) * 512]); }
            }
        }
        o = o / lsum;
        const float z = bf2f(ZB[(size_t)tok * 512 + h * 64 + lane]);
        const float v = o * z / (1.0f + __expf(-z));
        const float ss = wave_sum(v * v);
        if (lane == 0) red[h] = ss;
        __syncthreads();
        float ssb = 0.f, ssa = 0.f;
#pragma unroll
        for (int i = 0; i < 8; ++i) { ssb += red[i]; ssa += SSA[(size_t)tok * 8 + i]; }
        const float rsb = 1.0f / sqrtf(ssb * (1.0f / 512.0f) + EPS), rsa = 1.0f / sqrtf(ssa * (1.0f / 512.0f) + EPS);
        Y[(size_t)tok * DM + 512 + h * 64 + lane] = (bf16)f2bf(v * rsb / rsa);
        __syncthreads();
    }
}


typedef short bf16x8 __attribute__((ext_vector_type(8)));
typedef short s16x4 __attribute__((ext_vector_type(4)));
typedef float f32x16 __attribute__((ext_vector_type(16)));
typedef unsigned u32x2 __attribute__((ext_vector_type(2)));
struct AttnState { f32x16 o[2]; float m, l; };
__device__ __forceinline__ float swap_max(float v) { auto rr = __builtin_amdgcn_permlane32_swap(__float_as_uint(v), __float_as_uint(v), false, false); return fmaxf(__uint_as_float(rr[0]), __uint_as_float(rr[1])); }
__device__ __forceinline__ float swap_sum(float v) { auto rr = __builtin_amdgcn_permlane32_swap(__float_as_uint(v), __float_as_uint(v), false, false); return __uint_as_float(rr[0]) + __uint_as_float(rr[1]); }
__device__ __forceinline__ unsigned cvtpk(float lo, float hi) { unsigned r; asm volatile("v_cvt_pk_bf16_f32 %0, %1, %2" : "=v"(r) : "v"(lo), "v"(hi)); return r; }
__device__ __forceinline__ s16x4 vtr(const LAS unsigned char* p) { typedef short v4i16_t __attribute__((ext_vector_type(4))); return __builtin_bit_cast(s16x4, __builtin_amdgcn_ds_read_tr16_b64_v4i16((LAS v4i16_t*)p)); }
template <int NKT, class MaskF>
__device__ __forceinline__ void attn_step(AttnState& S, const bf16x8 (&qf)[4], const bf16x8 (&kf)[NKT][4], const LAS unsigned char* vrd, const MaskF& maskf) {
    f32x16 st[NKT];
#pragma unroll
    for (int p = 0; p < NKT; ++p) {
        st[p] = (f32x16){0.f, 0.f, 0.f, 0.f, 0.f, 0.f, 0.f, 0.f, 0.f, 0.f, 0.f, 0.f, 0.f, 0.f, 0.f, 0.f};
#pragma unroll
        for (int s = 0; s < 4; ++s) st[p] = __builtin_amdgcn_mfma_f32_32x32x16_bf16(kf[p][s], qf[s], st[p], 0, 0, 0);
    }
    float mx = -INFINITY;
#pragma unroll
    for (int p = 0; p < NKT; ++p)
#pragma unroll
        for (int r = 0; r < 16; ++r) { if (!maskf(p, r)) st[p][r] = -INFINITY; mx = fmaxf(mx, st[p][r]); }
    mx = swap_max(mx);
    const float m_new = fmaxf(S.m, mx);
    const float m_use = (m_new == -INFINITY) ? 0.f : m_new;
    const float alpha = __builtin_amdgcn_exp2f(S.m - m_use);
    S.m = m_new;
    float rs = 0.f;
#pragma unroll
    for (int p = 0; p < NKT; ++p)
#pragma unroll
        for (int r = 0; r < 16; ++r) { st[p][r] = __builtin_amdgcn_exp2f(st[p][r] - m_use); rs += st[p][r]; }
    S.l = S.l * alpha + rs;
#pragma unroll
    for (int r = 0; r < 16; ++r) { S.o[0][r] *= alpha; S.o[1][r] *= alpha; }
#pragma unroll
    for (int p = 0; p < NKT; ++p)
#pragma unroll
        for (int s2 = 0; s2 < 2; ++s2) {
            v4u pw; pw.x = cvtpk(st[p][8 * s2 + 0], st[p][8 * s2 + 1]); pw.y = cvtpk(st[p][8 * s2 + 2], st[p][8 * s2 + 3]); pw.z = cvtpk(st[p][8 * s2 + 4], st[p][8 * s2 + 5]); pw.w = cvtpk(st[p][8 * s2 + 6], st[p][8 * s2 + 7]);
            const bf16x8 pb = __builtin_bit_cast(bf16x8, pw);
#pragma unroll
            for (int n = 0; n < 2; ++n) {
                const s16x4 lo = vtr(vrd + (4 * p + 2 * s2) * 1024 + n * 512), hi4 = vtr(vrd + (4 * p + 2 * s2 + 1) * 1024 + n * 512);
                const bf16x8 va = (bf16x8){lo[0], lo[1], lo[2], lo[3], hi4[0], hi4[1], hi4[2], hi4[3]};
                S.o[n] = __builtin_amdgcn_mfma_f32_32x32x16_bf16(va, pb, S.o[n], 0, 0, 0);
            }
        }
}

__device__ __forceinline__ void p5_mixer_b_mfma(const Ctx& C, LAS unsigned char* lds) {
    const bf16* QB = (const bf16*)(C.ws + WS_QB); const bf16* KB = (const bf16*)(C.ws + WS_KB); const bf16* VB = (const bf16*)(C.ws + WS_VB); const bf16* ZB = (const bf16*)(C.ws + WS_ZB);
    const unsigned long long* MASK = (const unsigned long long*)(C.ws + WS_MASK);
    bf16* Y = (bf16*)(C.ws + WS_Y); const float* SSA = (const float*)(C.ws + WS_SSA);
    const int lane = C.lane, r = lane & 31, hi = lane >> 5, head = C.wave;
    LAS unsigned char* vl = lds + C.wave * 8192;
    LAS float* red = (LAS float*)(lds + 65536);
    const LAS unsigned char* vrd = vl + (4 * hi + ((lane & 15) >> 2)) * 64 + ((lane >> 4) & 1) * 32 + (lane & 3) * 8;
    LAS unsigned char* vwr = vl + (lane >> 3) * 64 + ((lane & 7) >> 2) * 512 + (lane & 3) * 16;
    for (int up = blockIdx.x; up < BATCH * 32; up += C.G) {
#pragma unroll 1
        for (int half = 0; half < 2; ++half) {
            const int b = up >> 5, qi = half ? 63 - (up & 31) : (up & 31);
            const size_t tokb = (size_t)b * SEQ; const int q0 = 32 * qi, nkt = (qi >> 1) + 1;
            const size_t qtok = tokb + q0 + r;
            bf16x8 qf[4];
#pragma unroll
            for (int s = 0; s < 4; ++s) qf[s] = *(const bf16x8*)(QB + qtok * 512 + head * 64 + 16 * s + 8 * hi);
            const unsigned long long* mrow = MASK + qtok * 32;
            AttnState S; S.m = -INFINITY; S.l = 0.f;
#pragma unroll
            for (int i = 0; i < 16; ++i) { S.o[0][i] = 0.f; S.o[1][i] = 0.f; }
            bf16x8 kn[2][4]; v4u vn[8]; unsigned long long wn;
            {
                const bf16* kp = KB + (tokb + r) * 64 + 8 * hi;
#pragma unroll
                for (int p = 0; p < 2; ++p)
#pragma unroll
                    for (int s = 0; s < 4; ++s) kn[p][s] = *(const bf16x8*)(kp + (size_t)p * 32 * 64 + 16 * s);
                const bf16* vp = VB + (tokb + (lane >> 3)) * 512 + head * 64 + (lane & 7) * 8;
#pragma unroll
                for (int i = 0; i < 8; ++i) vn[i] = *(const v4u*)(vp + (size_t)i * 8 * 512);
                wn = mrow[0];
            }
#pragma unroll 1
            for (int kt = 0; kt < nkt; ++kt) {
                bf16x8 kc[2][4];
#pragma unroll
                for (int p = 0; p < 2; ++p)
#pragma unroll
                    for (int s = 0; s < 4; ++s) kc[p][s] = kn[p][s];
                const unsigned long long wc = wn;
#pragma unroll
                for (int i = 0; i < 8; ++i) *(LAS v4u*)(vwr + i * 1024) = vn[i];
                if (kt + 1 < nkt) {
                    const bf16* kp = KB + (tokb + 64 * (kt + 1) + r) * 64 + 8 * hi;
#pragma unroll
                    for (int p = 0; p < 2; ++p)
#pragma unroll
                        for (int s = 0; s < 4; ++s) kn[p][s] = *(const bf16x8*)(kp + (size_t)p * 32 * 64 + 16 * s);
                    const bf16* vp = VB + (tokb + 64 * (kt + 1) + (lane >> 3)) * 512 + head * 64 + (lane & 7) * 8;
#pragma unroll
                    for (int i = 0; i < 8; ++i) vn[i] = *(const v4u*)(vp + (size_t)i * 8 * 512);
                    wn = mrow[kt + 1];
                }
                const unsigned wlo = (unsigned)(wc >> (4 * hi)), whi = (unsigned)(wc >> (32 + 4 * hi));
                auto maskf = [&](int p, int reg) -> bool { return (((p ? whi : wlo) >> ((reg & 3) + 8 * (reg >> 2))) & 1u) != 0u; };
                attn_step<2>(S, qf, kc, vrd, maskf);
            }
            const float linv = 1.0f / swap_sum(S.l);
            float ss = 0.f; float vv[2][16];
#pragma unroll
            for (int n = 0; n < 2; ++n)
#pragma unroll
                for (int g = 0; g < 4; ++g) {
                    const u32x2 zw = *(const u32x2*)(ZB + qtok * 512 + head * 64 + 32 * n + 8 * g + 4 * hi);
                    const float z[4] = {bflo(zw.x), bfhi(zw.x), bflo(zw.y), bfhi(zw.y)};
#pragma unroll
                    for (int e = 0; e < 4; ++e) { const float o = S.o[n][4 * g + e] * linv; const float v = o * z[e] / (1.0f + __expf(-z[e])); vv[n][4 * g + e] = v; ss += v * v; }
                }
            ss = swap_sum(ss);
            if (hi == 0) red[head * 32 + r] = ss;
            __syncthreads();
            float ssb = 0.f;
#pragma unroll
            for (int w = 0; w < 8; ++w) ssb += red[w * 32 + r];
            const f32x4 a0 = *(const f32x4*)(SSA + qtok * 8), a1 = *(const f32x4*)(SSA + qtok * 8 + 4);
            const float ssa = ((a0[0] + a0[1]) + (a0[2] + a0[3])) + ((a1[0] + a1[1]) + (a1[2] + a1[3]));
            const float scale = sqrtf(ssa * (1.0f / 512.0f) + EPS) / sqrtf(ssb * (1.0f / 512.0f) + EPS);
#pragma unroll
            for (int n = 0; n < 2; ++n)
#pragma unroll
                for (int g = 0; g < 4; ++g) {
                    u32x2 w; w.x = cvtpk(vv[n][4 * g] * scale, vv[n][4 * g + 1] * scale); w.y = cvtpk(vv[n][4 * g + 2] * scale, vv[n][4 * g + 3] * scale);
                    *(u32x2*)(Y + qtok * DM + 512 + head * 64 + 32 * n + 8 * g + 4 * hi) = w;
                }
            __syncthreads();
        }
    }
}

__device__ __forceinline__ void p7_final_norm(const Ctx& C) {
    for (int m = C.gw; m < M; m += C.NGW) {
        GAS f32x4* xr = (GAS f32x4*)(C.out + (size_t)m * DM) + C.lane;
        const GAS f32x4* gr = (const GAS f32x4*)C.g_fin + C.lane;
        f32x4 v[4]; float s = 0.f;
#pragma unroll
        for (int j = 0; j < 4; ++j) { v[j] = xr[64 * j]; s += (v[j].x * v[j].x + v[j].y * v[j].y) + (v[j].z * v[j].z + v[j].w * v[j].w); }
        const float rs = 1.0f / sqrtf(wave_sum(s) * (1.0f / DM) + EPS);
#pragma unroll
        for (int j = 0; j < 4; ++j) xr[64 * j] = v[j] * rs * gr[64 * j];
    }
}

#ifndef P5_MFMA
#define P5_MFMA 1
#endif
#ifndef P4_MFMA
#define P4_MFMA 0
#endif
struct Args { const void* in[12]; float* out; unsigned char* ws; int ph_lo, ph_hi, li, pad; };
__global__ void __launch_bounds__(NWAVES * 64, 2) mk_fwd(Args args) {
    extern __shared__ __attribute__((aligned(16))) unsigned char lds_raw[];
    LAS unsigned char* lds = (LAS unsigned char*)lds_raw;
    Ctx C;
    C.x = (const float*)args.in[0]; C.pos = (const int*)args.in[1]; C.g_in = (const float*)args.in[2]; C.w_in = (const float*)args.in[3]; C.g_kv = (const float*)args.in[4];
    C.w_uk = (const float*)args.in[5]; C.w_uv = (const float*)args.in[6]; C.g_ik = (const float*)args.in[7]; C.g_a = (const float*)args.in[8]; C.g_b = (const float*)args.in[9];
    C.w_out = (const float*)args.in[10]; C.g_fin = (const float*)args.in[11]; C.out = args.out; C.ws = args.ws;
    C.tid = threadIdx.x; C.lane = C.tid & 63; C.wave = __builtin_amdgcn_readfirstlane(C.tid >> 6); C.G = gridDim.x;
    C.gw = blockIdx.x * NWAVES + C.wave; C.NGW = C.G * NWAVES;
    volatile LAS unsigned* LCTL = (volatile LAS unsigned*)(lds + LDSCTL_OFF);
    if (C.tid < 64) LCTL[C.tid] = 0u;
    __syncthreads();
    gu32* ctl = (gu32*)(args.ws + WS_CTL);
    XcdBarrier bar; bar.bar = (unsigned*)(ctl + CW_BAR); bar.x = 0; bar.st = nullptr;
    if (N_LAUNCHES == 1) bar = xcd_barrier_post((unsigned*)(ctl + CW_BAR), LCTL);
    const int lo = args.ph_lo, hi = args.ph_hi;
#define IN(k) (lo <= (k) && (k) < hi)
#define SEAM(k) do { if (IN(k) && IN((k) + 1)) xcd_barrier(bar); } while (0)

    if (IN(0)) { p0_prologue(C, lds); SEAM(0); }
    if (IN(1)) {
        pg8::Gemm g{(const pg8::bf16_t*)(C.ws + WS_XN), (const pg8::bf16_t*)(C.ws + WS_WIN), M, NPROJ, DM}; pg8::StaticOrder S; S.init(M, NPROJ, C.G, (int)blockIdx.x);
        pg8::EpiProj E{C.ws, (const float*)(C.ws + WS_CS)};
        pg8::gemm_phase<pg8::EpiProj, pg8::StaticOrder, true, true>(lds, g, S, E);
        SEAM(1);
    }
    if (IN(2)) { p2_token_local(C, lds); SEAM(2); }
    if (IN(3)) { p3_indexer(C, lds); }
    if (IN(4)) { p4_mixer_a(C); SEAM(4); }
    if (IN(5)) { if (P5_MFMA) p5_mixer_b_mfma(C, lds); else p5_mixer_b(C, lds); SEAM(5); }
    if (IN(6)) {
        pg8::Gemm g{(const pg8::bf16_t*)(C.ws + WS_Y), (const pg8::bf16_t*)(C.ws + WS_WOUT), M, DM, DM}; pg8::StaticOrder S; S.init(M, DM, C.G, (int)blockIdx.x);
        pg8::EpiOut E{C.x, C.out, (const float*)(C.ws + WS_SSA)};
        pg8::gemm_phase<pg8::EpiOut, pg8::StaticOrder, true, true>(lds, g, S, E);
        SEAM(6);
    }
    if (IN(7)) { p7_final_norm(C); }
#undef IN
#undef SEAM
}

extern "C" void kernel_launch(void* const* d_in, const int* in_sizes, int n_in, void* d_out, int out_size, void* d_ws, size_t ws_size, hipStream_t stream) {
    static int grid = 0;
    if (grid == 0) {
        if (n_in != 12 || in_sizes[0] != M * DM || out_size != M * DM || ws_size < WS_END) { fprintf(stderr, "kernel_launch: unexpected shapes (n_in %d, in0 %d, out %d, ws %zu)\n", n_in, n_in > 0 ? in_sizes[0] : -1, out_size, ws_size); grid = -1; return; }
        int dev = 0, cus = 0, per_cu = 0;
        if (hipGetDevice(&dev) != hipSuccess || hipDeviceGetAttribute(&cus, hipDeviceAttributeMultiprocessorCount, dev) != hipSuccess) { grid = -1; return; }
        if (hipFuncSetAttribute((const void*)mk_fwd, hipFuncAttributeMaxDynamicSharedMemorySize, LDS_BYTES) != hipSuccess) { fprintf(stderr, "kernel_launch: hipFuncSetAttribute failed\n"); grid = -1; return; }
        if (hipOccupancyMaxActiveBlocksPerMultiprocessor(&per_cu, (const void*)mk_fwd, NWAVES * 64, LDS_BYTES) != hipSuccess || per_cu < 1) fprintf(stderr, "kernel_launch: occupancy query reports %d\n", per_cu);
        (void)hipGetLastError();
        grid = cus;
    }
    if (grid < 0) return;
    if (hipMemsetAsync((char*)d_ws + WS_CTL, 0, CTL_ZERO_BYTES, stream) != hipSuccess) return;
    Args a{};
    for (int i = 0; i < 12; ++i) a.in[i] = d_in[i];
    a.out = (float*)d_out; a.ws = (unsigned char*)d_ws;
    for (int li = 0; li < N_LAUNCHES; ++li) {
        a.ph_lo = (N_LAUNCHES == 1) ? 0 : li; a.ph_hi = (N_LAUNCHES == 1) ? N_PHASES : li + 1; a.li = li;
        hipLaunchKernelGGL(mk_fwd, dim3(grid), dim3(NWAVES * 64), LDS_BYTES, stream, a);
        const hipError_t le = hipPeekAtLastError();
        if (le != hipSuccess) { fprintf(stderr, "kernel_launch: launch %d failed: %s\n", li, hipGetErrorName(le)); break; }
    }
}
```

```cpp
#include <hip/hip_runtime.h>
#include <cstdio>
#include <cstdint>
namespace pg8 {
#define PG8_LAS __attribute__((address_space(3)))
typedef unsigned short bf16_t;
typedef short bf16x8 __attribute__((ext_vector_type(8)));
typedef float f32x4 __attribute__((ext_vector_type(4)));
typedef unsigned u32x4 __attribute__((ext_vector_type(4)));
constexpr int BM = 256, BK = 64, HALF = 128, HTB = HALF * BK * 2  , STAGE_BYTES = 8 * HTB, NXCD = 8, WGM = 8;

__host__ __device__ __forceinline__ int lds_byte(int r, int c) { const int st = (r >> 4) * 2 + (c >> 5), rr = r & 15, cc = c & 31, ob = rr * 64 + cc * 2; return st * 1024 + (ob ^ (((ob >> 9) & 1) << 5)); }
__host__ __device__ __forceinline__ void stage_rc(int b, int& R, int& C) { const int st = b / 1024, sb = b % 1024, swz = sb ^ (((sb >> 9) & 1) << 5); R = (st >> 1) * 16 + swz / 64; C = (st & 1) * 32 + (swz % 64) / 2; }
__host__ __device__ __forceinline__ int perm32(int rho) { const int n = rho >> 4, i = rho & 15; return 8 * (i >> 2) + 4 * n + (i & 3); }

struct Unit { int pm, pn; };
struct Gemm { const bf16_t* A; const bf16_t* Bt; int M, N, K; };

struct StaticOrder {
    int nM, nN, nwg, G, c;
    __host__ __device__ void init(int M, int N, int G_, int c_) { nM = M / BM; nN = N / BM; nwg = nM * nN; G = G_; c = c_; }
    __host__ __device__ bool next(int i, Unit& u) const {
        const long L = (long)i * G + c; if (L >= nwg) return false;
        int wgid = (int)L; { const int q = nwg / NXCD, r = nwg % NXCD, xcd = wgid % NXCD, off = wgid / NXCD; wgid = (xcd < r ? xcd * (q + 1) : r * (q + 1) + (xcd - r) * q) + off; }
        const int nig = WGM * nN, gid = wgid / nig, fm = gid * WGM, gsz = (nM - fm) < WGM ? (nM - fm) : WGM;
        u.pm = fm + ((wgid % nig) % gsz); u.pn = (wgid % nig) / gsz; return true;
    }
    __device__ __forceinline__ void a_ready(const Unit&) const {}
    __device__ __forceinline__ void done(const Unit&) const {}
};

template <class Epi, class Sched, bool ALIGN_EPI = false, bool SP2 = false>
__device__ __forceinline__ void gemm_phase(PG8_LAS unsigned char* lds, const Gemm g, const Sched& S, const Epi& E) {
    const int tid = threadIdx.x, wid = __builtin_amdgcn_readfirstlane(tid >> 6), lane = tid & 63, wr = wid >> 2, wc = wid & 3, fr = lane & 15, fq = lane >> 4;
    const int K = g.K, nt = K / BK;
    unsigned voffA[2], voffB[2];
#pragma unroll
    for (int i = 0; i < 2; ++i) { int R, C; stage_rc(tid * 16 + i * 8192, R, C); const int Rb = Epi::PERM ? ((R & ~31) + perm32(R & 31)) : R;
        voffA[i] = (unsigned)(R * K + C) * 2u; voffB[i] = (unsigned)(Rb * K + C) * 2u; }
    const size_t kstep = (size_t)(BK * 2);
    const size_t hstep = (size_t)HALF * K * 2;
    const size_t tstep = 2 * hstep;
    const unsigned ldsw = (unsigned)wid * 1024u;
    const int aoff = lds_byte(wr * 64 + fr, fq * 8), boff = lds_byte(wc * 32 + fr, fq * 8);
#define PG8_SA(b, h) (((b) * 2 + (h)) * HTB)
#define PG8_SB(b, h) ((4 + (b) * 2 + (h)) * HTB)
#define PG8_STAGE(bufoff, gbase, voff) do { _Pragma("unroll") for (int _i = 0; _i < 2; ++_i) \
        __builtin_amdgcn_global_load_lds((const unsigned*)((const char*)(gbase) + (voff)[_i]), (PG8_LAS unsigned*)(lds + (bufoff) + ldsw + _i * 8192), 16, 0, 0); } while (0)
#define PG8_LDA(dst, b, h) do { _Pragma("unroll") for (int m = 0; m < 4; ++m) _Pragma("unroll") for (int k = 0; k < 2; ++k) dst[m][k] = *(const PG8_LAS bf16x8*)(lds + PG8_SA(b, h) + aoff + m * 2048 + k * 1024); } while (0)
#define PG8_LDB(dst, b, h) do { _Pragma("unroll") for (int n = 0; n < 2; ++n) _Pragma("unroll") for (int k = 0; k < 2; ++k) dst[n][k] = *(const PG8_LAS bf16x8*)(lds + PG8_SB(b, h) + boff + n * 2048 + k * 1024); } while (0)
#define PG8_MMA(ai, bj, At, Bt) do { __builtin_amdgcn_s_setprio(1); _Pragma("unroll") for (int m = 0; m < 4; ++m) _Pragma("unroll") for (int n = 0; n < 2; ++n) _Pragma("unroll") for (int k = 0; k < 2; ++k) \
        acc[ai][bj][m][n] = __builtin_amdgcn_mfma_f32_16x16x32_bf16(Bt[n][k], At[m][k], acc[ai][bj][m][n], 0, 0, 0); __builtin_amdgcn_s_setprio(0); } while (0)
#define PG8_WAIT_V(n) asm volatile("s_waitcnt vmcnt(" #n ")" ::: "memory")
#define PG8_WAIT_L(n) asm volatile("s_waitcnt lgkmcnt(" #n ")" ::: "memory")
#define PG8_BAR __builtin_amdgcn_s_barrier()
#define PG8_SCHED __builtin_amdgcn_sched_barrier(0)
    Unit cur, nxt; int ui = 0;
    if (!S.next(0, cur)) return;
    f32x4 acc[2][2][4][2];
#pragma unroll
    for (int a = 0; a < 2; ++a)
#pragma unroll
        for (int b = 0; b < 2; ++b)
#pragma unroll
            for (int m = 0; m < 4; ++m)
#pragma unroll
                for (int n = 0; n < 2; ++n) acc[a][b][m][n] = (f32x4){0.f, 0.f, 0.f, 0.f};
    bf16x8 At[4][2], B0[2][2], B1[2][2];
    const char* cA = (const char*)g.A + (size_t)cur.pm * tstep; const char* cB = (const char*)g.Bt + (size_t)cur.pn * tstep;
    S.a_ready(cur);
    if constexpr (SP2) {
        PG8_STAGE(PG8_SB(0, 0), cB, voffB); PG8_STAGE(PG8_SB(0, 1), cB + hstep, voffB); PG8_STAGE(PG8_SA(0, 0), cA, voffA); PG8_STAGE(PG8_SA(0, 1), cA + hstep, voffA);
        if (wr == 1) PG8_BAR;
        PG8_WAIT_V(2); PG8_BAR;
        PG8_STAGE(PG8_SB(1, 0), cB + kstep, voffB); PG8_STAGE(PG8_SA(1, 0), cA + kstep, voffA); PG8_STAGE(PG8_SB(1, 1), cB + hstep + kstep, voffB);
        PG8_WAIT_V(6); PG8_BAR;
    } else {
        PG8_STAGE(PG8_SB(0, 0), cB, voffB); PG8_STAGE(PG8_SA(0, 0), cA, voffA); PG8_STAGE(PG8_SB(0, 1), cB + hstep, voffB); PG8_STAGE(PG8_SA(0, 1), cA + hstep, voffA);
        if (wr == 1) PG8_BAR;
        PG8_WAIT_V(4); PG8_BAR;
        PG8_STAGE(PG8_SB(1, 0), cB + kstep, voffB); PG8_STAGE(PG8_SA(1, 0), cA + kstep, voffA); PG8_STAGE(PG8_SB(1, 1), cB + hstep + kstep, voffB);
        PG8_WAIT_V(6); PG8_BAR;
    }
    for (;;) {
        const bool has_next = S.next(ui + 1, nxt);
        const char* nA = has_next ? (const char*)g.A + (size_t)nxt.pm * tstep : cA; const char* nB = has_next ? (const char*)g.Bt + (size_t)nxt.pn * tstep : cB;
        for (int t = 0; t < nt; t += 2) {
            const bool last = (t == nt - 2);
            const char* a1 = cA + (size_t)(t + 1) * kstep;
            const char* a2 = last ? nA : cA + (size_t)(t + 2) * kstep; const char* b2 = last ? nB : cB + (size_t)(t + 2) * kstep;
            const char* a3 = a2 + kstep; const char* b3 = b2 + kstep;
            if (last && has_next) S.a_ready(nxt);
            if constexpr (SP2) {
            PG8_LDB(B0, 0, 0); PG8_LDB(B1, 0, 1); PG8_SCHED; PG8_LDA(At, 0, 0); PG8_STAGE(PG8_SA(1, 1), a1 + hstep, voffA);
            PG8_WAIT_V(8); PG8_WAIT_L(0); PG8_BAR; PG8_MMA(0, 0, At, B0); PG8_MMA(0, 1, At, B1); PG8_BAR; PG8_SCHED;
            PG8_LDA(At, 0, 1); PG8_STAGE(PG8_SB(0, 0), b2, voffB); PG8_STAGE(PG8_SB(0, 1), b2 + hstep, voffB); PG8_STAGE(PG8_SA(0, 0), a2, voffA);
            PG8_WAIT_V(8); PG8_WAIT_L(0); PG8_BAR; PG8_MMA(1, 0, At, B0); PG8_MMA(1, 1, At, B1); PG8_BAR; PG8_SCHED;
            PG8_LDB(B0, 1, 0); PG8_LDB(B1, 1, 1); PG8_SCHED; PG8_LDA(At, 1, 0); PG8_STAGE(PG8_SA(0, 1), a2 + hstep, voffA);
            PG8_WAIT_V(8); PG8_WAIT_L(0); PG8_BAR; PG8_MMA(0, 0, At, B0); PG8_MMA(0, 1, At, B1); PG8_BAR; PG8_SCHED;
            PG8_LDA(At, 1, 1); PG8_STAGE(PG8_SB(1, 0), b3, voffB); PG8_STAGE(PG8_SB(1, 1), b3 + hstep, voffB); PG8_STAGE(PG8_SA(1, 0), a3, voffA);
            PG8_WAIT_V(8); PG8_WAIT_L(0); PG8_BAR; PG8_MMA(1, 0, At, B0); PG8_MMA(1, 1, At, B1); PG8_BAR; PG8_SCHED;
            } else {
            PG8_LDB(B0, 0, 0); PG8_SCHED; PG8_LDA(At, 0, 0); PG8_STAGE(PG8_SA(1, 1), a1 + hstep, voffA);
            PG8_WAIT_L(8); PG8_BAR; PG8_WAIT_L(0); PG8_MMA(0, 0, At, B0); PG8_BAR; PG8_SCHED;
            PG8_LDB(B1, 0, 1); PG8_STAGE(PG8_SB(0, 0), b2, voffB);
            PG8_BAR; PG8_WAIT_L(0); PG8_MMA(0, 1, At, B1); PG8_BAR;
            PG8_LDA(At, 0, 1); PG8_STAGE(PG8_SA(0, 0), a2, voffA);
            PG8_BAR; PG8_WAIT_L(0); PG8_MMA(1, 0, At, B0); PG8_BAR; PG8_SCHED;
            PG8_STAGE(PG8_SB(0, 1), b2 + hstep, voffB);
            PG8_WAIT_V(6); PG8_BAR; PG8_MMA(1, 1, At, B1); PG8_BAR;
            PG8_LDB(B0, 1, 0); PG8_SCHED; PG8_LDA(At, 1, 0); PG8_STAGE(PG8_SA(0, 1), a2 + hstep, voffA);
            PG8_WAIT_L(8); PG8_BAR; PG8_WAIT_L(0); PG8_MMA(0, 0, At, B0); PG8_BAR; PG8_SCHED;
            PG8_LDB(B1, 1, 1); PG8_STAGE(PG8_SB(1, 0), b3, voffB);
            PG8_BAR; PG8_WAIT_L(0); PG8_MMA(0, 1, At, B1); PG8_BAR;
            PG8_LDA(At, 1, 1); PG8_STAGE(PG8_SA(1, 0), a3, voffA);
            PG8_BAR; PG8_WAIT_L(0); PG8_MMA(1, 0, At, B0); PG8_BAR; PG8_SCHED;
            PG8_STAGE(PG8_SB(1, 1), b3 + hstep, voffB);
            PG8_WAIT_V(6); PG8_BAR; PG8_MMA(1, 1, At, B1); PG8_BAR;
            }
        }
        if constexpr (ALIGN_EPI) { if (wr == 0) PG8_BAR; }
        if constexpr (!Epi::AFTER_DRAIN) { E(acc, cur, wr, wc, fr, fq); S.done(cur); }
        if (!has_next) break;
#pragma unroll
        for (int a = 0; a < 2; ++a)
#pragma unroll
            for (int b = 0; b < 2; ++b)
#pragma unroll
                for (int m = 0; m < 4; ++m)
#pragma unroll
                    for (int n = 0; n < 2; ++n) acc[a][b][m][n] = (f32x4){0.f, 0.f, 0.f, 0.f};
        cur = nxt; cA = nA; cB = nB; ++ui;
        if constexpr (ALIGN_EPI) { if (wr == 1) PG8_BAR; }
    }
    PG8_WAIT_V(0);
    if constexpr (!ALIGN_EPI) { if (wr == 0) PG8_BAR; }
    PG8_BAR;
    if constexpr (Epi::AFTER_DRAIN) { E.fused(acc, cur, wr, wc, fr, fq, lds, wid, lane); S.done(cur); }
#undef PG8_SA
#undef PG8_SB
#undef PG8_STAGE
#undef PG8_LDA
#undef PG8_LDB
#undef PG8_MMA
#undef PG8_WAIT_V
#undef PG8_WAIT_L
#undef PG8_BAR
#undef PG8_SCHED
}
}

#ifndef MK_N_LAUNCHES
#define MK_N_LAUNCHES 1
#endif
constexpr int N_LAUNCHES = MK_N_LAUNCHES;
constexpr int N_PHASES = 8;

constexpr int NWAVES = 8;
constexpr int BATCH = 16, SEQ = 2048, DM = 1024, M = BATCH * SEQ;
constexpr int DIN = 3524, NPROJ = 3584;
constexpr float EPS = 1e-6f;
constexpr float C2 = 0.125f * 1.4426950408889634f;

constexpr size_t MiB = 1u << 20;
constexpr size_t WS_CTL = 0, CTL_ZERO_BYTES = 1 * MiB;
constexpr size_t WS_WIN = 2 * MiB;
constexpr size_t WS_WOUT = 10 * MiB;
constexpr size_t WS_CS = 12 * MiB;
constexpr size_t WS_SSA = 14 * MiB;
constexpr size_t WS_XN = 16 * MiB;
constexpr size_t WS_Y = WS_XN;
constexpr size_t WS_QA = 80 * MiB;
constexpr size_t WS_KA = WS_QA + 32 * MiB, WS_VA = WS_QA + 64 * MiB, WS_ZA = WS_QA + 96 * MiB, WS_QB = WS_QA + 128 * MiB, WS_ZB = WS_QA + 160 * MiB;
constexpr size_t WS_IQ = 272 * MiB;
constexpr size_t WS_MISC = 288 * MiB;
constexpr size_t WS_KB = 320 * MiB;
constexpr size_t WS_VB = 324 * MiB;
constexpr size_t WS_IKN = 356 * MiB;
constexpr size_t WS_IW = 364 * MiB;
constexpr size_t WS_MASK = 366 * MiB;
constexpr size_t WS_END = 376 * MiB;
constexpr int CW_BAR = 4096;

constexpr int LDS_BYTES = 155648;
constexpr int LDSCTL_OFF = LDS_BYTES - 256;

#define GAS __attribute__((address_space(1)))
#define LAS __attribute__((address_space(3)))
typedef unsigned short bf16;
typedef unsigned v4u __attribute__((ext_vector_type(4)));
typedef float f32x4 __attribute__((ext_vector_type(4)));
typedef GAS unsigned gu32;
#define RLX_AGENT __ATOMIC_RELAXED, __HIP_MEMORY_SCOPE_AGENT
__device__ __forceinline__ unsigned f2bf(float f) { unsigned u = __builtin_bit_cast(unsigned, f); return (u + 0x7fffu + ((u >> 16) & 1u)) >> 16; }
__device__ __forceinline__ unsigned pk2(float lo, float hi) { return f2bf(lo) | (f2bf(hi) << 16); }
__device__ __forceinline__ float bf2f(unsigned short h) { return __builtin_bit_cast(float, (unsigned)h << 16); }
__device__ __forceinline__ float bflo(unsigned w) { return __builtin_bit_cast(float, w << 16); }
__device__ __forceinline__ float bfhi(unsigned w) { return __builtin_bit_cast(float, w & 0xffff0000u); }
__device__ __forceinline__ float wave_sum(float v) {
#pragma unroll
    for (int o = 1; o < 64; o <<= 1) v += __shfl_xor(v, o);
    return v;
}
__device__ __forceinline__ float wave_max(float v) {
#pragma unroll
    for (int o = 1; o < 64; o <<= 1) v = fmaxf(v, __shfl_xor(v, o));
    return v;
}

#define XB_TMO      128
#define XB_XCNT(j)  (256  + 64 * (j))
#define XB_XSUB(j)  (1280 + 64 * (j))
#define XB_XGEN(j)  (2304 + 64 * (j))
#define XB_TOP      3328
#define XB_TOPGEN   3392
#define XCD_BAR_WORDS 3456
#define XB_SPIN_CAP (1u << 18)

__device__ __forceinline__ unsigned xb_ld(unsigned* p)              { return __hip_atomic_load(p, __ATOMIC_RELAXED, __HIP_MEMORY_SCOPE_AGENT); }
__device__ __forceinline__ unsigned xb_add(unsigned* p, unsigned v) { return __hip_atomic_fetch_add(p, v, __ATOMIC_RELAXED, __HIP_MEMORY_SCOPE_AGENT); }
__device__ __forceinline__ unsigned xb_xcc_id() { return (unsigned)__builtin_amdgcn_s_getreg((3 << 11) | 20) & 0xFu; }
#define XB_SPIN(cond, bar) do { unsigned _sp = 0; while (cond) { __builtin_amdgcn_s_sleep(1); \
    if ((++_sp & 255u) == 0u) { if (xb_ld(&(bar)[XB_TMO])) break; if (_sp > XB_SPIN_CAP) { atomicAdd(&(bar)[XB_TMO], 1u); break; } } } } while (0)

struct XcdBarrier {
    unsigned* bar; unsigned x;
    volatile LAS unsigned* st;
};

__device__ __forceinline__ XcdBarrier xcd_barrier_post(unsigned* bar, volatile LAS unsigned* st) {
    XcdBarrier b; b.bar = bar; b.x = xb_xcc_id(); b.st = st;
    if (threadIdx.x == 0) (void)xb_add(&bar[XB_XCNT(b.x)], 1u);
    return b;
}
__device__ __forceinline__ void xcd_barrier_complete(unsigned* bar, unsigned x, unsigned& nloc, unsigned& nx) {
    const unsigned G = gridDim.x * gridDim.y * gridDim.z;
    unsigned sum, cnt, mine, sp = 0u;
    for (;;) {
        sum = 0u; cnt = 0u; mine = 0u;
#pragma unroll
        for (unsigned j = 0; j < 16; ++j) { const unsigned c = xb_ld(&bar[XB_XCNT(j)]); sum += c; cnt += (c > 0u) ? 1u : 0u; mine = (j == x) ? c : mine; }
        if (sum == G) break;
        __builtin_amdgcn_s_sleep(1);
        if ((++sp & 255u) == 0u) { if (xb_ld(&bar[XB_TMO])) break; if (sp > XB_SPIN_CAP) { atomicAdd(&bar[XB_TMO], 1u); break; } }
    }
    nloc = mine > 0u ? mine : 1u; nx = cnt > 0u ? cnt : 1u;
}

__device__ __forceinline__ void xcd_barrier(const XcdBarrier& b) {
    asm volatile("s_waitcnt vmcnt(0)" ::: "memory");
    __syncthreads();
    if (threadIdx.x == 0) {
        unsigned* bar = b.bar;
        __builtin_amdgcn_s_waitcnt(0);
        unsigned nloc = b.st[0], nx = b.st[1];
        if (nloc == 0u) { xcd_barrier_complete(bar, b.x, nloc, nx); b.st[0] = nloc; b.st[1] = nx; }
        const unsigned old = xb_add(&bar[XB_XSUB(b.x)], 1u);
        const unsigned gen = old / nloc;
        if (old + 1u == (gen + 1u) * nloc) {
            __builtin_amdgcn_fence(__ATOMIC_RELEASE, "agent");
            asm volatile("s_waitcnt vmcnt(0)" ::: "memory");
            const unsigned og = xb_add(&bar[XB_TOP], 1u);
            const unsigned tg = og / nx;
            if (og + 1u == (tg + 1u) * nx) xb_add(&bar[XB_TOPGEN], 1u);
            else XB_SPIN(xb_ld(&bar[XB_TOPGEN]) == tg, bar);
            __builtin_amdgcn_fence(__ATOMIC_ACQUIRE, "agent");
            xb_add(&bar[XB_XGEN(b.x)], 1u);
            asm volatile("s_waitcnt vmcnt(0)" ::: "memory");
        } else {
            XB_SPIN(xb_ld(&bar[XB_XGEN(b.x)]) == gen, bar);
            __builtin_amdgcn_fence(__ATOMIC_ACQUIRE, "agent");
            asm volatile("s_waitcnt vmcnt(0)" ::: "memory");
        }
    }
    __syncthreads();
}


struct Ctx {
    const float* x; const int* pos; const float* g_in; const float* w_in; const float* g_kv; const float* w_uk; const float* w_uv; const float* g_ik;
    const float* g_a; const float* g_b; const float* w_out; const float* g_fin;
    float* out; unsigned char* ws;
    int tid, lane, wave, G, gw, NGW;
};

namespace pg8 {
__device__ __forceinline__ unsigned cvt_pk_bf16(float lo, float hi) { unsigned r; asm volatile("v_cvt_pk_bf16_f32 %0, %1, %2" : "=v"(r) : "v"(lo), "v"(hi)); return r; }
struct EpiProj {
    static constexpr bool PERM = true, AFTER_DRAIN = false;
    unsigned char* ws; const float* cs;
    __device__ __forceinline__ void operator()(const f32x4 (&acc)[2][2][4][2], const Unit& u, int wr, int wc, int fr, int fq) const {
        const int pn = u.pn;
        const int row0 = u.pm * BM + wr * 64 + fr;
        if (pn == 13) {
            float* base = (float*)(ws + WS_MISC) + wc * 32 + 8 * fq;
#pragma unroll
            for (int ai = 0; ai < 2; ++ai)
#pragma unroll
                for (int m = 0; m < 4; ++m) { float* rowp = base + (size_t)(row0 + ai * HALF + m * 16) * 256;
#pragma unroll
                    for (int bj = 0; bj < 2; ++bj) { *(f32x4*)(rowp + bj * HALF) = acc[ai][bj][m][0]; *(f32x4*)(rowp + bj * HALF + 4) = acc[ai][bj][m][1]; } }
            return;
        }
        bf16_t* base; int ld;
        if (pn == 12) { base = (bf16_t*)(ws + WS_IQ); ld = 256; }
        else { base = (bf16_t*)(ws + WS_QA + (size_t)(pn >> 1) * (32 * MiB)) + (pn & 1) * 256; ld = 512; }
        const bool rope = (pn < 4) || (pn == 8) || (pn == 9) || (pn == 12);
        const float sc = (pn < 2 || pn == 8 || pn == 9) ? C2 : 1.0f;
        const bool ropew = rope && ((wc & 1) == 0);
        base += wc * 32 + 8 * fq;
#pragma unroll
        for (int ai = 0; ai < 2; ++ai)
#pragma unroll
            for (int m = 0; m < 4; ++m) {
                const int row = row0 + ai * HALF + m * 16;
                bf16_t* rowp = base + (size_t)row * ld;
                f32x4 c0 = {1.f, 1.f, 1.f, 1.f}, c1 = c0, s0 = {0.f, 0.f, 0.f, 0.f}, s1 = s0;
                if (ropew) { const f32x4* cp = (const f32x4*)(cs + (size_t)row * 16); c0 = cp[0]; c1 = cp[1]; s0 = cp[2]; s1 = cp[3]; if (fq == 0) { s0 = -s0; s1 = -s1; } if (fq >= 2) { c0 = (f32x4){1.f, 1.f, 1.f, 1.f}; c1 = c0; s0 = (f32x4){0.f, 0.f, 0.f, 0.f}; s1 = s0; } }
#pragma unroll
                for (int bj = 0; bj < 2; ++bj) {
                    f32x4 v0 = acc[ai][bj][m][0], v1 = acc[ai][bj][m][1];
                    if (ropew) {
                        f32x4 p0, p1;
#pragma unroll
                        for (int e = 0; e < 4; ++e) { p0[e] = __shfl_xor(v0[e], 16); p1[e] = __shfl_xor(v1[e], 16); }
                        v0 = v0 * c0 + p0 * s0; v1 = v1 * c1 + p1 * s1;
                    }
                    v0 = v0 * sc; v1 = v1 * sc;
                    u32x4 w; w.x = cvt_pk_bf16(v0[0], v0[1]); w.y = cvt_pk_bf16(v0[2], v0[3]); w.z = cvt_pk_bf16(v1[0], v1[1]); w.w = cvt_pk_bf16(v1[2], v1[3]);
                    *(u32x4*)(rowp + bj * HALF) = w;
                }
            }
    }
};
struct EpiOut {
    static constexpr bool PERM = false, AFTER_DRAIN = false;
    const float* x; float* out; const float* ssa;
    __device__ __forceinline__ void operator()(const f32x4 (&acc)[2][2][4][2], const Unit& u, int wr, int wc, int fr, int fq) const {
        const int col0 = u.pn * BM + wc * 32 + 4 * fq;
#pragma unroll
        for (int ai = 0; ai < 2; ++ai)
#pragma unroll
            for (int m = 0; m < 4; ++m) {
                const int r = u.pm * BM + ai * HALF + wr * 64 + m * 16 + fr;
                const f32x4 a0 = *(const f32x4*)(ssa + (size_t)r * 8), a1 = *(const f32x4*)(ssa + (size_t)r * 8 + 4);
                const float ss = ((a0[0] + a0[1]) + (a0[2] + a0[3])) + ((a1[0] + a1[1]) + (a1[2] + a1[3]));
                const float rs = 1.0f / sqrtf(ss * (1.0f / 512.0f) + EPS);
                const size_t off = (size_t)r * DM + col0;
#pragma unroll
                for (int bj = 0; bj < 2; ++bj)
#pragma unroll
                    for (int n = 0; n < 2; ++n) { const f32x4 xv = *(const f32x4*)(x + off + bj * HALF + n * 16); *(f32x4*)(out + off + bj * HALF + n * 16) = xv + acc[ai][bj][m][n] * rs; }
            }
    }
};
}

__device__ __forceinline__ void p0_transpose_item(const float* W, int ldw, int srccol0, int nvalid, const float* rowgain, bf16* WT, int K, int n0, int k0, LAS float* scr, int lane) {
#pragma unroll 8
    for (int i = 0; i < 32; ++i) { const int kk = 2 * i + (lane >> 5), n = lane & 31; float v = 0.f; if (n < nvalid) { v = W[(size_t)(k0 + kk) * ldw + srccol0 + n]; if (rowgain) v *= rowgain[k0 + kk]; } scr[kk * 33 + n] = v; }
    asm volatile("s_waitcnt lgkmcnt(0)" ::: "memory");
    const int c = lane & 7;
#pragma unroll
    for (int j = 0; j < 4; ++j) { const int n = (lane >> 3) + 8 * j; const LAS float* s = scr + (8 * c) * 33 + n;
        v4u o; o.x = pk2(s[0 * 33], s[1 * 33]); o.y = pk2(s[2 * 33], s[3 * 33]); o.z = pk2(s[4 * 33], s[5 * 33]); o.w = pk2(s[6 * 33], s[7 * 33]);
        *(GAS v4u*)(WT + (size_t)(n0 + n) * K + k0 + 8 * c) = o; }
    asm volatile("s_waitcnt lgkmcnt(0)" ::: "memory");
}
__device__ __forceinline__ void p0_prologue(const Ctx& C, LAS unsigned char* lds) {
    LAS float* scr = (LAS float*)(lds + C.wave * 16384);
    constexpr int I1 = 16 * (NPROJ / 32), I2 = 16 * (DM / 32);
    for (int it = C.gw; it < I1 + I2; it += C.NGW) {
        if (it < I1) {
            const int kb = it / (NPROJ / 32), nb = it % (NPROJ / 32), n0 = 32 * nb;
            int src;
            if (n0 < 2560) src = n0; else if (n0 < 3072) src = 2688 + (n0 - 2560); else if (n0 < 3328) src = 3200 + (n0 - 3072); else if (n0 < 3456) src = 2560 + (n0 - 3328); else src = n0;
            const int nvalid = (n0 + 32 <= DIN) ? 32 : (n0 < DIN ? DIN - n0 : 0);
            p0_transpose_item(C.w_in, DIN, src, nvalid, nullptr, (bf16*)(C.ws + WS_WIN), DM, n0, 64 * kb, scr, C.lane);
        } else {
            const int r = it - I1, kb = r / (DM / 32), nb = r % (DM / 32);
            const float* gain = (kb < 8) ? C.g_a : (C.g_b - 512);
            p0_transpose_item(C.w_out, DM, 32 * nb, 32, gain, (bf16*)(C.ws + WS_WOUT), DM, 32 * nb, 64 * kb, scr, C.lane);
        }
    }
    for (int m = C.gw; m < M; m += C.NGW) {
        const GAS f32x4* xr = (const GAS f32x4*)(C.x + (size_t)m * DM) + C.lane;
        const GAS f32x4* gr = (const GAS f32x4*)C.g_in + C.lane;
        f32x4 v[4]; float s = 0.f;
#pragma unroll
        for (int j = 0; j < 4; ++j) { v[j] = xr[64 * j]; s += (v[j].x * v[j].x + v[j].y * v[j].y) + (v[j].z * v[j].z + v[j].w * v[j].w); }
        const float rs = 1.0f / sqrtf(wave_sum(s) * (1.0f / DM) + EPS);
        GAS unsigned long long* o8 = (GAS unsigned long long*)((bf16*)(C.ws + WS_XN) + (size_t)m * DM) + C.lane;
#pragma unroll
        for (int j = 0; j < 4; ++j) { const f32x4 g = gr[64 * j]; o8[64 * j] = (unsigned long long)pk2(v[j].x * rs * g.x, v[j].y * rs * g.y) | ((unsigned long long)pk2(v[j].z * rs * g.z, v[j].w * rs * g.w) << 32); }
    }
    for (int e = blockIdx.x * (NWAVES * 64) + C.tid; e < M * 8; e += C.G * NWAVES * 64) {
        const int tok = e >> 3, j = e & 7;
        const float inv = exp2f(-(float)j * (18.931568569324174f / 8.0f));
        const float ang = (float)C.pos[tok] * inv;
        const double rev = (double)ang * 0.15915494309189535;
        const float fr = (float)(rev - rint(rev));
        float* cs = (float*)(C.ws + WS_CS) + (size_t)tok * 16;
        cs[j] = __builtin_amdgcn_cosf(fr); cs[8 + j] = __builtin_amdgcn_sinf(fr);
    }
}

__device__ __forceinline__ void p2_token_local(const Ctx& C, LAS unsigned char* lds) {
    LAS float* ck = (LAS float*)(lds + C.wave * 16384);
    const int lane = C.lane;
    const float* misc = (const float*)(C.ws + WS_MISC);
    const float* cs = (const float*)(C.ws + WS_CS);
    for (int grp = C.gw; grp < M / 8; grp += C.NGW) {
        const int tok0 = grp * 8;
#pragma unroll 1
        for (int tt = 0; tt < 8; ++tt) {
            const int tok = tok0 + tt; const float* mr = misc + (size_t)tok * 256;
            const float a = mr[2 * lane], b = mr[2 * lane + 1];
            const float rs = 1.0f / sqrtf(wave_sum(a * a + b * b) * (1.0f / 128.0f) + EPS);
            ck[tt * 128 + 2 * lane] = a * rs * C.g_kv[2 * lane]; ck[tt * 128 + 2 * lane + 1] = b * rs * C.g_kv[2 * lane + 1];
            const float k = mr[128 + lane];
            const float rk = 1.0f / sqrtf(wave_sum(k * k) * (1.0f / 64.0f) + EPS);
            float kn = k * rk * C.g_ik[lane];
            const float partner = __shfl_xor(kn, 8);
            if (lane < 16) { const float c = cs[(size_t)tok * 16 + (lane & 7)], s = cs[(size_t)tok * 16 + 8 + (lane & 7)]; kn = (lane < 8) ? kn * c - partner * s : kn * c + partner * s; }
            ((bf16*)(C.ws + WS_IKN))[(size_t)tok * 64 + lane] = (bf16)f2bf(kn);
            if (lane < 4) ((float*)(C.ws + WS_IW))[(size_t)tok * 4 + lane] = mr[192 + lane] * 0.0625f;
        }
        asm volatile("s_waitcnt lgkmcnt(0)" ::: "memory");
        float acc[9][8];
#pragma unroll
        for (int i = 0; i < 9; ++i)
#pragma unroll
            for (int t = 0; t < 8; ++t) acc[i][t] = 0.f;
#pragma unroll 2
        for (int c = 0; c < 128; ++c) {
            float w[9]; w[0] = C.w_uk[c * 64 + lane];
#pragma unroll
            for (int h = 0; h < 8; ++h) w[1 + h] = C.w_uv[(size_t)(h * 128 + c) * 64 + lane];
#pragma unroll
            for (int t = 0; t < 8; ++t) { const float a = ck[t * 128 + c];
#pragma unroll
                for (int i = 0; i < 9; ++i) acc[i][t] += a * w[i]; }
        }
#pragma unroll
        for (int t = 0; t < 8; ++t) {
            const int tok = tok0 + t;
            float kb = acc[0][t];
            const float partner = __shfl_xor(kb, 8);
            if (lane < 16) { const float c = cs[(size_t)tok * 16 + (lane & 7)], s = cs[(size_t)tok * 16 + 8 + (lane & 7)]; kb = (lane < 8) ? kb * c - partner * s : kb * c + partner * s; }
            ((bf16*)(C.ws + WS_KB))[(size_t)tok * 64 + lane] = (bf16)f2bf(kb);
#pragma unroll
            for (int h = 0; h < 8; ++h) ((bf16*)(C.ws + WS_VB))[(size_t)tok * 512 + h * 64 + lane] = (bf16)f2bf(acc[1 + h][t]);
        }
        asm volatile("s_waitcnt lgkmcnt(0)" ::: "memory");
    }
}

__device__ __forceinline__ void select_topk(const LAS float* srow, int t, unsigned long long* maskrow, int lane) {
    unsigned key[32];
#pragma unroll
    for (int j = 0; j < 32; ++j) { const int s = 64 * j + lane; unsigned u = 0u; if (s <= t) { const unsigned f = __float_as_uint(srow[s]); u = (f & 0x80000000u) ? ~f : (f | 0x80000000u); } key[j] = u; }
    const int nregs = (t >> 6) + 1;
    unsigned long long myword = 0ull;
    if (t + 1 <= 256) {
#pragma unroll
        for (int j = 0; j < 32; ++j) { const unsigned long long b = __builtin_amdgcn_ballot_w64(key[j] != 0u); if (lane == j) myword = b; }
    } else {
        unsigned T = 0u; bool exact = false;
        for (int bit = 31; bit >= 0; --bit) {
            const unsigned cand = T | (1u << bit);
            int c = 0;
#pragma unroll
            for (int j = 0; j < 32; ++j) if (j < nregs) c += __builtin_popcountll(__builtin_amdgcn_ballot_w64(key[j] >= cand));
            if (c >= 256) { T = cand; if (c == 256) { exact = true; break; } }
        }
        if (exact) {
#pragma unroll
            for (int j = 0; j < 32; ++j) { const unsigned long long b = __builtin_amdgcn_ballot_w64(key[j] >= T); if (lane == j) myword = b; }
        } else {
            int cgt = 0;
#pragma unroll
            for (int j = 0; j < 32; ++j) cgt += __builtin_popcountll(__builtin_amdgcn_ballot_w64(key[j] > T));
            const int r = 256 - cgt; int running = 0;
            const unsigned long long ltmask = (1ull << lane) - 1ull;
#pragma unroll
            for (int j = 0; j < 32; ++j) {
                const unsigned long long eq = __builtin_amdgcn_ballot_w64(key[j] == T);
                const int pre = running + __builtin_popcountll(eq & ltmask);
                const bool s = (key[j] > T) || (key[j] == T && pre < r);
                const unsigned long long b = __builtin_amdgcn_ballot_w64(s);
                if (lane == j) myword = b;
                running += __builtin_popcountll(eq);
            }
        }
    }
    if (lane < 32) maskrow[lane] = myword;
}
__device__ __forceinline__ void p3_indexer(const Ctx& C, LAS unsigned char* lds) {
    LAS float* scores = (LAS float*)lds;
    LAS float* iql = (LAS float*)(lds + 131072);
    LAS float* iwl = (LAS float*)(lds + 131072 + 16384);
    const bf16* IQ = (const bf16*)(C.ws + WS_IQ); const bf16* IKN = (const bf16*)(C.ws + WS_IKN); const float* IW = (const float*)(C.ws + WS_IW);
    unsigned long long* MASK = (unsigned long long*)(C.ws + WS_MASK);
    for (int unit = blockIdx.x; unit < BATCH * (SEQ / 16); unit += C.G) {
        const int b = unit / (SEQ / 16), t0 = (unit % (SEQ / 16)) * 16; const size_t tokb = (size_t)b * SEQ;
        {
            const int idx = C.tid * 8; const v4u w = *(const GAS v4u*)(IQ + (tokb + t0 + (idx >> 8)) * 256 + (idx & 255));
            LAS float* d = iql + idx; d[0] = bflo(w.x); d[1] = bfhi(w.x); d[2] = bflo(w.y); d[3] = bfhi(w.y); d[4] = bflo(w.z); d[5] = bfhi(w.z); d[6] = bflo(w.w); d[7] = bfhi(w.w);
            if (C.tid < 64) iwl[C.tid] = IW[(tokb + t0) * 4 + C.tid];
        }
        __syncthreads();
        const int nkeys = t0 + 16;
        for (int s = C.tid; s < nkeys; s += NWAVES * 64) {
            float k[64];
            const GAS v4u* kp = (const GAS v4u*)(IKN + (tokb + s) * 64);
#pragma unroll
            for (int i = 0; i < 8; ++i) { const v4u w = kp[i]; k[8 * i] = bflo(w.x); k[8 * i + 1] = bfhi(w.x); k[8 * i + 2] = bflo(w.y); k[8 * i + 3] = bfhi(w.y); k[8 * i + 4] = bflo(w.z); k[8 * i + 5] = bfhi(w.z); k[8 * i + 6] = bflo(w.w); k[8 * i + 7] = bfhi(w.w); }
#pragma unroll 1
            for (int q = 0; q < 16; ++q) {
                float sc = 0.f;
#pragma unroll
                for (int h = 0; h < 4; ++h) {
                    const LAS f32x4* qp = (const LAS f32x4*)(iql + q * 256 + h * 64);
                    float d0 = 0.f, d1 = 0.f;
#pragma unroll
                    for (int i = 0; i < 16; ++i) { const f32x4 qv = qp[i]; d0 += qv.x * k[4 * i] + qv.z * k[4 * i + 2]; d1 += qv.y * k[4 * i + 1] + qv.w * k[4 * i + 3]; }
                    sc += iwl[q * 4 + h] * fmaxf(d0 + d1, 0.f);
                }
                scores[q * 2048 + s] = sc;
            }
        }
        __syncthreads();
#pragma unroll 1
        for (int qq = 0; qq < 2; ++qq) { const int q = C.wave * 2 + qq, t = t0 + q; select_topk(scores + q * 2048, t, MASK + (tokb + t) * 32, C.lane); }
        __syncthreads();
    }
}

__device__ __forceinline__ void p4_mixer_a(const Ctx& C) {
    const bf16* QA = (const bf16*)(C.ws + WS_QA); const bf16* KA = (const bf16*)(C.ws + WS_KA); const bf16* VA = (const bf16*)(C.ws + WS_VA); const bf16* ZA = (const bf16*)(C.ws + WS_ZA);
    bf16* Y = (bf16*)(C.ws + WS_Y); float* SSA = (float*)(C.ws + WS_SSA);
    const int lane = C.lane;
    for (int job = C.gw; job < M * 8; job += C.NGW) {
        const int tok = job >> 3, h = job & 7, b = tok / SEQ, t = tok % SEQ; const size_t tokb = (size_t)b * SEQ;
        float qf[64];
        { const GAS v4u* qp = (const GAS v4u*)(QA + (size_t)tok * 512 + h * 64);
#pragma unroll
          for (int i = 0; i < 8; ++i) { const v4u w = qp[i]; qf[8 * i] = bflo(w.x); qf[8 * i + 1] = bfhi(w.x); qf[8 * i + 2] = bflo(w.y); qf[8 * i + 3] = bfhi(w.y); qf[8 * i + 4] = bflo(w.z); qf[8 * i + 5] = bfhi(w.z); qf[8 * i + 6] = bflo(w.w); qf[8 * i + 7] = bfhi(w.w); } }
        float sv[7]; int pv[7]; float mx = -INFINITY;
#pragma unroll
        for (int i = 0; i < 7; ++i) {
            const int e = lane + 64 * i; int d, j;
            if (e < 129) { d = 1; j = e; } else if (e < 258) { d = 4; j = e - 129; } else { d = 16; j = e - 258; }
            const int p = t - j * d; const bool valid = (e < 387) && (p >= 0);
            float s = -INFINITY;
            if (valid) { const GAS v4u* kp = (const GAS v4u*)(KA + (tokb + p) * 512 + h * 64); float a0 = 0.f, a1 = 0.f;
#pragma unroll
                for (int c = 0; c < 8; ++c) { const v4u w = kp[c]; a0 += qf[8 * c] * bflo(w.x) + qf[8 * c + 2] * bflo(w.y) + qf[8 * c + 4] * bflo(w.z) + qf[8 * c + 6] * bflo(w.w); a1 += qf[8 * c + 1] * bfhi(w.x) + qf[8 * c + 3] * bfhi(w.y) + qf[8 * c + 5] * bfhi(w.z) + qf[8 * c + 7] * bfhi(w.w); }
                s = a0 + a1; }
            sv[i] = s; pv[i] = valid ? p : 0; mx = fmaxf(mx, s);
        }
        mx = wave_max(mx);
        float lsum = 0.f;
#pragma unroll
        for (int i = 0; i < 7; ++i) { sv[i] = exp2f(sv[i] - mx); lsum += sv[i]; }
        lsum = wave_sum(lsum);
        float o = 0.f;
        const bf16* vcol = VA + tokb * 512 + h * 64 + lane;
#pragma unroll
        for (int i = 0; i < 7; ++i) {
            const int cnt = (i < 6) ? 64 : 3;
#pragma unroll 8
            for (int l2 = 0; l2 < cnt; ++l2) { const float pp = __builtin_bit_cast(float, __builtin_amdgcn_readlane(__builtin_bit_cast(int, sv[i]), l2)); const int ps = __builtin_amdgcn_readlane(pv[i], l2);
                o += pp * bf2f(vcol[(size_t)ps * 512]); }
        }
        o = o / lsum;
        const float z = bf2f(ZA[(size_t)tok * 512 + h * 64 + lane]);
        const float v = o * z / (1.0f + __expf(-z));
        const float ss = wave_sum(v * v);
        if (lane == 0) SSA[(size_t)tok * 8 + h] = ss;
        Y[(size_t)tok * DM + h * 64 + lane] = (bf16)f2bf(v);
    }
}

__device__ __forceinline__ void p5_mixer_b(const Ctx& C, LAS unsigned char* lds) {
    const bf16* QB = (const bf16*)(C.ws + WS_QB); const bf16* KB = (const bf16*)(C.ws + WS_KB); const bf16* VB = (const bf16*)(C.ws + WS_VB); const bf16* ZB = (const bf16*)(C.ws + WS_ZB);
    const unsigned long long* MASK = (const unsigned long long*)(C.ws + WS_MASK);
    bf16* Y = (bf16*)(C.ws + WS_Y); const float* SSA = (const float*)(C.ws + WS_SSA);
    LAS float* red = (LAS float*)lds;
    const int lane = C.lane, h = C.wave;
    for (int tok = blockIdx.x; tok < M; tok += C.G) {
        const int b = tok / SEQ, t = tok % SEQ; const size_t tokb = (size_t)b * SEQ;
        float qf[64];
        { const GAS v4u* qp = (const GAS v4u*)(QB + (size_t)tok * 512 + h * 64);
#pragma unroll
          for (int i = 0; i < 8; ++i) { const v4u w = qp[i]; qf[8 * i] = bflo(w.x); qf[8 * i + 1] = bfhi(w.x); qf[8 * i + 2] = bflo(w.y); qf[8 * i + 3] = bfhi(w.y); qf[8 * i + 4] = bflo(w.z); qf[8 * i + 5] = bfhi(w.z); qf[8 * i + 6] = bflo(w.w); qf[8 * i + 7] = bfhi(w.w); } }
        const int nw = (t >> 6) + 1;
        float sv[32]; float mx = -INFINITY;
#pragma unroll
        for (int j = 0; j < 32; ++j) {
            float s = -INFINITY;
            if (j < nw) {
                const unsigned long long w = MASK[(size_t)tok * 32 + j];
                if ((w >> lane) & 1ull) { const GAS v4u* kp = (const GAS v4u*)(KB + (tokb + 64 * j + lane) * 64); float a0 = 0.f, a1 = 0.f;
#pragma unroll
                    for (int c = 0; c < 8; ++c) { const v4u x = kp[c]; a0 += qf[8 * c] * bflo(x.x) + qf[8 * c + 2] * bflo(x.y) + qf[8 * c + 4] * bflo(x.z) + qf[8 * c + 6] * bflo(x.w); a1 += qf[8 * c + 1] * bfhi(x.x) + qf[8 * c + 3] * bfhi(x.y) + qf[8 * c + 5] * bfhi(x.z) + qf[8 * c + 7] * bfhi(x.w); }
                    s = a0 + a1; }
            }
            sv[j] = s; mx = fmaxf(mx, s);
        }
        mx = wave_max(mx);
        float lsum = 0.f;
#pragma unroll
        for (int j = 0; j < 32; ++j) { sv[j] = exp2f(sv[j] - mx); lsum += sv[j]; }
        lsum = wave_sum(lsum);
        float o = 0.f;
        const bf16* vcol = VB + tokb * 512 + h * 64 + lane;
#pragma unroll
        for (int j = 0; j < 32; ++j) {
            if (j < nw) {
                const unsigned long long wv = MASK[(size_t)tok * 32 + j];
                unsigned wlo = __builtin_amdgcn_readfirstlane((unsigned)wv), whi = __builtin_amdgcn_readfirstlane((unsigned)(wv >> 32));
                unsigned long long w = ((unsigned long long)whi << 32) | wlo;
                while (w) { const int l2 = __builtin_ctzll(w); w &= w - 1ull;
                    const float pp = __builtin_bit_cast(float, __builtin_amdgcn_readlane(__builtin_bit_cast(int, sv[j]), l2));
                    o += pp * bf2f(vcol[(size_t)(64 * j + l2) * 512]); }
            }
        }
        o = o / lsum;
        const float z = bf2f(ZB[(size_t)tok * 512 + h * 64 + lane]);
        const float v = o * z / (1.0f + __expf(-z));
        const float ss = wave_sum(v * v);
        if (lane == 0) red[h] = ss;
        __syncthreads();
        float ssb = 0.f, ssa = 0.f;
#pragma unroll
        for (int i = 0; i < 8; ++i) { ssb += red[i]; ssa += SSA[(size_t)tok * 8 + i]; }
        const float rsb = 1.0f / sqrtf(ssb * (1.0f / 512.0f) + EPS), rsa = 1.0f / sqrtf(ssa * (1.0f / 512.0f) + EPS);
        Y[(size_t)tok * DM + 512 + h * 64 + lane] = (bf16)f2bf(v * rsb / rsa);
        __syncthreads();
    }
}


typedef short bf16x8 __attribute__((ext_vector_type(8)));
typedef short s16x4 __attribute__((ext_vector_type(4)));
typedef float f32x16 __attribute__((ext_vector_type(16)));
typedef unsigned u32x2 __attribute__((ext_vector_type(2)));
struct AttnState { f32x16 o[2]; float m, l; };
__device__ __forceinline__ float swap_max(float v) { auto rr = __builtin_amdgcn_permlane32_swap(__float_as_uint(v), __float_as_uint(v), false, false); return fmaxf(__uint_as_float(rr[0]), __uint_as_float(rr[1])); }
__device__ __forceinline__ float swap_sum(float v) { auto rr = __builtin_amdgcn_permlane32_swap(__float_as_uint(v), __float_as_uint(v), false, false); return __uint_as_float(rr[0]) + __uint_as_float(rr[1]); }
__device__ __forceinline__ unsigned cvtpk(float lo, float hi) { unsigned r; asm volatile("v_cvt_pk_bf16_f32 %0, %1, %2" : "=v"(r) : "v"(lo), "v"(hi)); return r; }
__device__ __forceinline__ s16x4 vtr(const LAS unsigned char* p) { typedef short v4i16_t __attribute__((ext_vector_type(4))); return __builtin_bit_cast(s16x4, __builtin_amdgcn_ds_read_tr16_b64_v4i16((LAS v4i16_t*)p)); }
template <int NKT, class MaskF>
__device__ __forceinline__ void attn_step(AttnState& S, const bf16x8 (&qf)[4], const bf16x8 (&kf)[NKT][4], const LAS unsigned char* vrd, const MaskF& maskf) {
    f32x16 st[NKT];
#pragma unroll
    for (int p = 0; p < NKT; ++p) {
        st[p] = (f32x16){0.f, 0.f, 0.f, 0.f, 0.f, 0.f, 0.f, 0.f, 0.f, 0.f, 0.f, 0.f, 0.f, 0.f, 0.f, 0.f};
#pragma unroll
        for (int s = 0; s < 4; ++s) st[p] = __builtin_amdgcn_mfma_f32_32x32x16_bf16(kf[p][s], qf[s], st[p], 0, 0, 0);
    }
    float mx = -INFINITY;
#pragma unroll
    for (int p = 0; p < NKT; ++p)
#pragma unroll
        for (int r = 0; r < 16; ++r) { if (!maskf(p, r)) st[p][r] = -INFINITY; mx = fmaxf(mx, st[p][r]); }
    mx = swap_max(mx);
    const float m_new = fmaxf(S.m, mx);
    const float m_use = (m_new == -INFINITY) ? 0.f : m_new;
    const float alpha = __builtin_amdgcn_exp2f(S.m - m_use);
    S.m = m_new;
    float rs = 0.f;
#pragma unroll
    for (int p = 0; p < NKT; ++p)
#pragma unroll
        for (int r = 0; r < 16; ++r) { st[p][r] = __builtin_amdgcn_exp2f(st[p][r] - m_use); rs += st[p][r]; }
    S.l = S.l * alpha + rs;
#pragma unroll
    for (int r = 0; r < 16; ++r) { S.o[0][r] *= alpha; S.o[1][r] *= alpha; }
#pragma unroll
    for (int p = 0; p < NKT; ++p)
#pragma unroll
        for (int s2 = 0; s2 < 2; ++s2) {
            v4u pw; pw.x = cvtpk(st[p][8 * s2 + 0], st[p][8 * s2 + 1]); pw.y = cvtpk(st[p][8 * s2 + 2], st[p][8 * s2 + 3]); pw.z = cvtpk(st[p][8 * s2 + 4], st[p][8 * s2 + 5]); pw.w = cvtpk(st[p][8 * s2 + 6], st[p][8 * s2 + 7]);
            const bf16x8 pb = __builtin_bit_cast(bf16x8, pw);
#pragma unroll
            for (int n = 0; n < 2; ++n) {
                const s16x4 lo = vtr(vrd + (4 * p + 2 * s2) * 1024 + n * 512), hi4 = vtr(vrd + (4 * p + 2 * s2 + 1) * 1024 + n * 512);
                const bf16x8 va = (bf16x8){lo[0], lo[1], lo[2], lo[3], hi4[0], hi4[1], hi4[2], hi4[3]};
                S.o[n] = __builtin_amdgcn_mfma_f32_32x32x16_bf16(va, pb, S.o[n], 0, 0, 0);
            }
        }
}

__device__ __forceinline__ void p5_mixer_b_mfma(const Ctx& C, LAS unsigned char* lds) {
    const bf16* QB = (const bf16*)(C.ws + WS_QB); const bf16* KB = (const bf16*)(C.ws + WS_KB); const bf16* VB = (const bf16*)(C.ws + WS_VB); const bf16* ZB = (const bf16*)(C.ws + WS_ZB);
    const unsigned long long* MASK = (const unsigned long long*)(C.ws + WS_MASK);
    bf16* Y = (bf16*)(C.ws + WS_Y); const float* SSA = (const float*)(C.ws + WS_SSA);
    const int lane = C.lane, r = lane & 31, hi = lane >> 5, head = C.wave;
    LAS unsigned char* vl = lds + C.wave * 8192;
    LAS float* red = (LAS float*)(lds + 65536);
    const LAS unsigned char* vrd = vl + (4 * hi + ((lane & 15) >> 2)) * 64 + ((lane >> 4) & 1) * 32 + (lane & 3) * 8;
    LAS unsigned char* vwr = vl + (lane >> 3) * 64 + ((lane & 7) >> 2) * 512 + (lane & 3) * 16;
    for (int up = blockIdx.x; up < BATCH * 32; up += C.G) {
#pragma unroll 1
        for (int half = 0; half < 2; ++half) {
            const int b = up >> 5, qi = half ? 63 - (up & 31) : (up & 31);
            const size_t tokb = (size_t)b * SEQ; const int q0 = 32 * qi, nkt = (qi >> 1) + 1;
            const size_t qtok = tokb + q0 + r;
            bf16x8 qf[4];
#pragma unroll
            for (int s = 0; s < 4; ++s) qf[s] = *(const bf16x8*)(QB + qtok * 512 + head * 64 + 16 * s + 8 * hi);
            const unsigned long long* mrow = MASK + qtok * 32;
            AttnState S; S.m = -INFINITY; S.l = 0.f;
#pragma unroll
            for (int i = 0; i < 16; ++i) { S.o[0][i] = 0.f; S.o[1][i] = 0.f; }
            bf16x8 kn[2][4]; v4u vn[8]; unsigned long long wn;
            {
                const bf16* kp = KB + (tokb + r) * 64 + 8 * hi;
#pragma unroll
                for (int p = 0; p < 2; ++p)
#pragma unroll
                    for (int s = 0; s < 4; ++s) kn[p][s] = *(const bf16x8*)(kp + (size_t)p * 32 * 64 + 16 * s);
                const bf16* vp = VB + (tokb + (lane >> 3)) * 512 + head * 64 + (lane & 7) * 8;
#pragma unroll
                for (int i = 0; i < 8; ++i) vn[i] = *(const v4u*)(vp + (size_t)i * 8 * 512);
                wn = mrow[0];
            }
#pragma unroll 1
            for (int kt = 0; kt < nkt; ++kt) {
                bf16x8 kc[2][4];
#pragma unroll
                for (int p = 0; p < 2; ++p)
#pragma unroll
                    for (int s = 0; s < 4; ++s) kc[p][s] = kn[p][s];
                const unsigned long long wc = wn;
#pragma unroll
                for (int i = 0; i < 8; ++i) *(LAS v4u*)(vwr + i * 1024) = vn[i];
                if (kt + 1 < nkt) {
                    const bf16* kp = KB + (tokb + 64 * (kt + 1) + r) * 64 + 8 * hi;
#pragma unroll
                    for (int p = 0; p < 2; ++p)
#pragma unroll
                        for (int s = 0; s < 4; ++s) kn[p][s] = *(const bf16x8*)(kp + (size_t)p * 32 * 64 + 16 * s);
                    const bf16* vp = VB + (tokb + 64 * (kt + 1) + (lane >> 3)) * 512 + head * 64 + (lane & 7) * 8;
#pragma unroll
                    for (int i = 0; i < 8; ++i) vn[i] = *(const v4u*)(vp + (size_t)i * 8 * 512);
                    wn = mrow[kt + 1];
                }
                const unsigned wlo = (unsigned)(wc >> (4 * hi)), whi = (unsigned)(wc >> (32 + 4 * hi));
                auto maskf = [&](int p, int reg) -> bool { return (((p ? whi : wlo) >> ((reg & 3) + 8 * (reg >> 2))) & 1u) != 0u; };
                attn_step<2>(S, qf, kc, vrd, maskf);
            }
            const float linv = 1.0f / swap_sum(S.l);
            float ss = 0.f; float vv[2][16];
#pragma unroll
            for (int n = 0; n < 2; ++n)
#pragma unroll
                for (int g = 0; g < 4; ++g) {
                    const u32x2 zw = *(const u32x2*)(ZB + qtok * 512 + head * 64 + 32 * n + 8 * g + 4 * hi);
                    const float z[4] = {bflo(zw.x), bfhi(zw.x), bflo(zw.y), bfhi(zw.y)};
#pragma unroll
                    for (int e = 0; e < 4; ++e) { const float o = S.o[n][4 * g + e] * linv; const float v = o * z[e] / (1.0f + __expf(-z[e])); vv[n][4 * g + e] = v; ss += v * v; }
                }
            ss = swap_sum(ss);
            if (hi == 0) red[head * 32 + r] = ss;
            __syncthreads();
            float ssb = 0.f;
#pragma unroll
            for (int w = 0; w < 8; ++w) ssb += red[w * 32 + r];
            const f32x4 a0 = *(const f32x4*)(SSA + qtok * 8), a1 = *(const f32x4*)(SSA + qtok * 8 + 4);
            const float ssa = ((a0[0] + a0[1]) + (a0[2] + a0[3])) + ((a1[0] + a1[1]) + (a1[2] + a1[3]));
            const float scale = sqrtf(ssa * (1.0f / 512.0f) + EPS) / sqrtf(ssb * (1.0f / 512.0f) + EPS);
#pragma unroll
            for (int n = 0; n < 2; ++n)
#pragma unroll
                for (int g = 0; g < 4; ++g) {
                    u32x2 w; w.x = cvtpk(vv[n][4 * g] * scale, vv[n][4 * g + 1] * scale); w.y = cvtpk(vv[n][4 * g + 2] * scale, vv[n][4 * g + 3] * scale);
                    *(u32x2*)(Y + qtok * DM + 512 + head * 64 + 32 * n + 8 * g + 4 * hi) = w;
                }
            __syncthreads();
        }
    }
}


__device__ __forceinline__ void p4_mixer_a_mfma(const Ctx& C, LAS unsigned char* lds) {
    const bf16* QA = (const bf16*)(C.ws + WS_QA); const bf16* KA = (const bf16*)(C.ws + WS_KA); const bf16* VA = (const bf16*)(C.ws + WS_VA); const bf16* ZA = (const bf16*)(C.ws + WS_ZA);
    bf16* Y = (bf16*)(C.ws + WS_Y); float* SSA = (float*)(C.ws + WS_SSA);
    const int lane = C.lane, r = lane & 31, hi = lane >> 5, w = C.wave;
    LAS unsigned char* vl = lds + w * 8192;
    LAS float* OST = (LAS float*)(lds + 65536);
    LAS float* MST = (LAS float*)(lds + 65536 + 69632);
    LAS float* LST = MST + 256;
    const LAS unsigned char* vrd = vl + (4 * hi + ((lane & 15) >> 2)) * 64 + ((lane >> 4) & 1) * 32 + (lane & 3) * 8;
    LAS unsigned char* vwr = vl + (lane >> 3) * 64 + ((lane & 7) >> 2) * 512 + (lane & 3) * 16;
    for (int unit = blockIdx.x; unit < BATCH * 64; unit += C.G) {
        const int b = unit >> 6, c = (unit >> 3) & 7, head = unit & 7, t0 = 256 * c; const size_t tokb = (size_t)b * SEQ;
        const bf16* Kh = KA + tokb * 512 + head * 64; const bf16* Vh = VA + tokb * 512 + head * 64;
#pragma unroll 1
        for (int jj = 0; jj < 4; ++jj) {
            if (jj == 1 || jj == 2) __syncthreads();
            int ld, rr, j0, nq;
            if (jj == 0) { ld = 0; rr = 0; j0 = t0 + 32 * w; nq = 32; }
            else if (jj == 1) { ld = 2; rr = w & 3; j0 = (t0 >> 2) + 32 * (w >> 2); nq = 32; }
            else { ld = 4; rr = 2 * w + (jj - 2); j0 = t0 >> 4; nq = 16; }
            const bool rowok = r < nq;
            const int jq = j0 + (rowok ? r : nq - 1);
            const int qpos = (jq << ld) + rr, lrow = qpos - t0;
            const size_t qtok = tokb + qpos;
            bf16x8 qf[4];
#pragma unroll
            for (int s = 0; s < 4; ++s) qf[s] = *(const bf16x8*)(QA + qtok * 512 + head * 64 + 16 * s + 8 * hi);
            AttnState S;
            if (jj == 0) {
                S.m = -INFINITY; S.l = 0.f;
#pragma unroll
                for (int i = 0; i < 16; ++i) { S.o[0][i] = 0.f; S.o[1][i] = 0.f; }
            } else {
                S.m = MST[lrow]; S.l = LST[hi * 256 + lrow];
#pragma unroll
                for (int n = 0; n < 2; ++n)
#pragma unroll
                    for (int g = 0; g < 4; ++g) { const f32x4 v = *(const LAS f32x4*)(OST + lrow * 68 + 32 * n + 8 * g + 4 * hi); S.o[n][4 * g] = v[0]; S.o[n][4 * g + 1] = v[1]; S.o[n][4 * g + 2] = v[2]; S.o[n][4 * g + 3] = v[3]; }
            }
            const int ks = j0 - 128;
            const unsigned lim = (unsigned)(jq < 128 ? jq : 128);
            const int dq0 = rowok ? (jq - ks - 4 * hi) : -100000;
            const bool act0 = (ks + 63 >= 0), act1 = (ks + 127 >= 0);
            bf16x8 kn[2][4]; v4u vn[8];
            auto load_tile = [&](int i) {
#pragma unroll
                for (int p = 0; p < 2; ++p) { int jk = ks + 64 * i + 32 * p + r; jk = jk < 0 ? 0 : jk; int ps = (jk << ld) + rr; ps = ps > SEQ - 1 ? SEQ - 1 : ps; const bf16* kp = Kh + (size_t)ps * 512 + 8 * hi;
#pragma unroll
                    for (int s = 0; s < 4; ++s) kn[p][s] = *(const bf16x8*)(kp + 16 * s); }
#pragma unroll
                for (int ii = 0; ii < 8; ++ii) { int jk = ks + 64 * i + 8 * ii + (lane >> 3); jk = jk < 0 ? 0 : jk; int ps = (jk << ld) + rr; ps = ps > SEQ - 1 ? SEQ - 1 : ps; vn[ii] = *(const v4u*)(Vh + (size_t)ps * 512 + (lane & 7) * 8); }
            };
            const int i0 = act0 ? 0 : (act1 ? 1 : 2);
            load_tile(i0);
#pragma unroll 1
            for (int i = i0; i < 3; ++i) {
                bf16x8 kc[2][4];
#pragma unroll
                for (int p = 0; p < 2; ++p)
#pragma unroll
                    for (int s = 0; s < 4; ++s) kc[p][s] = kn[p][s];
#pragma unroll
                for (int ii = 0; ii < 8; ++ii) *(LAS v4u*)(vwr + ii * 1024) = vn[ii];
                if (i + 1 < 3) load_tile(i + 1);
                const int dq = dq0 - 64 * i;
                auto maskf = [&](int p, int reg) -> bool { return (unsigned)(dq - 32 * p - ((reg & 3) + 8 * (reg >> 2))) <= lim; };
                if (i < 2) attn_step<2>(S, qf, kc, vrd, maskf);
                else { const bf16x8 (&k1)[1][4] = *reinterpret_cast<const bf16x8 (*)[1][4]>(&kc[0]); attn_step<1>(S, qf, k1, vrd, maskf); }
            }
            if (jj < 2) {
                if (hi == 0) MST[lrow] = S.m;
                LST[hi * 256 + lrow] = S.l;
#pragma unroll
                for (int n = 0; n < 2; ++n)
#pragma unroll
                    for (int g = 0; g < 4; ++g) *(LAS f32x4*)(OST + lrow * 68 + 32 * n + 8 * g + 4 * hi) = (f32x4){S.o[n][4 * g], S.o[n][4 * g + 1], S.o[n][4 * g + 2], S.o[n][4 * g + 3]};
            } else {
                const float linv = 1.0f / swap_sum(S.l);
                float ss = 0.f; float vv[2][16];
#pragma unroll
                for (int n = 0; n < 2; ++n)
#pragma unroll
                    for (int g = 0; g < 4; ++g) {
                        const u32x2 zw = *(const u32x2*)(ZA + qtok * 512 + head * 64 + 32 * n + 8 * g + 4 * hi);
                        const float z[4] = {bflo(zw.x), bfhi(zw.x), bflo(zw.y), bfhi(zw.y)};
#pragma unroll
                        for (int e = 0; e < 4; ++e) { const float o = S.o[n][4 * g + e] * linv; const float v = o * z[e] / (1.0f + __expf(-z[e])); vv[n][4 * g + e] = v; ss += v * v; }
                    }
                ss = swap_sum(ss);
                if (rowok) {
                    if (hi == 0) SSA[qtok * 8 + head] = ss;
#pragma unroll
                    for (int n = 0; n < 2; ++n)
#pragma unroll
                        for (int g = 0; g < 4; ++g) { u32x2 wv; wv.x = cvtpk(vv[n][4 * g], vv[n][4 * g + 1]); wv.y = cvtpk(vv[n][4 * g + 2], vv[n][4 * g + 3]); *(u32x2*)(Y + qtok * DM + head * 64 + 32 * n + 8 * g + 4 * hi) = wv; }
                }
            }
        }
        __syncthreads();
    }
}

__device__ __forceinline__ void p7_final_norm(const Ctx& C) {
    for (int m = C.gw; m < M; m += C.NGW) {
        GAS f32x4* xr = (GAS f32x4*)(C.out + (size_t)m * DM) + C.lane;
        const GAS f32x4* gr = (const GAS f32x4*)C.g_fin + C.lane;
        f32x4 v[4]; float s = 0.f;
#pragma unroll
        for (int j = 0; j < 4; ++j) { v[j] = xr[64 * j]; s += (v[j].x * v[j].x + v[j].y * v[j].y) + (v[j].z * v[j].z + v[j].w * v[j].w); }
        const float rs = 1.0f / sqrtf(wave_sum(s) * (1.0f / DM) + EPS);
#pragma unroll
        for (int j = 0; j < 4; ++j) xr[64 * j] = v[j] * rs * gr[64 * j];
    }
}

#ifndef P5_MFMA
#define P5_MFMA 1
#endif
#ifndef P4_MFMA
#define P4_MFMA 1
#endif
struct Args { const void* in[12]; float* out; unsigned char* ws; int ph_lo, ph_hi, li, pad; };
__global__ void __launch_bounds__(NWAVES * 64, 2) mk_fwd(Args args) {
    extern __shared__ __attribute__((aligned(16))) unsigned char lds_raw[];
    LAS unsigned char* lds = (LAS unsigned char*)lds_raw;
    Ctx C;
    C.x = (const float*)args.in[0]; C.pos = (const int*)args.in[1]; C.g_in = (const float*)args.in[2]; C.w_in = (const float*)args.in[3]; C.g_kv = (const float*)args.in[4];
    C.w_uk = (const float*)args.in[5]; C.w_uv = (const float*)args.in[6]; C.g_ik = (const float*)args.in[7]; C.g_a = (const float*)args.in[8]; C.g_b = (const float*)args.in[9];
    C.w_out = (const float*)args.in[10]; C.g_fin = (const float*)args.in[11]; C.out = args.out; C.ws = args.ws;
    C.tid = threadIdx.x; C.lane = C.tid & 63; C.wave = __builtin_amdgcn_readfirstlane(C.tid >> 6); C.G = gridDim.x;
    C.gw = blockIdx.x * NWAVES + C.wave; C.NGW = C.G * NWAVES;
    volatile LAS unsigned* LCTL = (volatile LAS unsigned*)(lds + LDSCTL_OFF);
    if (C.tid < 64) LCTL[C.tid] = 0u;
    __syncthreads();
    gu32* ctl = (gu32*)(args.ws + WS_CTL);
    XcdBarrier bar; bar.bar = (unsigned*)(ctl + CW_BAR); bar.x = 0; bar.st = nullptr;
    if (N_LAUNCHES == 1) bar = xcd_barrier_post((unsigned*)(ctl + CW_BAR), LCTL);
    const int lo = args.ph_lo, hi = args.ph_hi;
#define IN(k) (lo <= (k) && (k) < hi)
#define SEAM(k) do { if (IN(k) && IN((k) + 1)) xcd_barrier(bar); } while (0)

    if (IN(0)) { p0_prologue(C, lds); SEAM(0); }
    if (IN(1)) {
        pg8::Gemm g{(const pg8::bf16_t*)(C.ws + WS_XN), (const pg8::bf16_t*)(C.ws + WS_WIN), M, NPROJ, DM}; pg8::StaticOrder S; S.init(M, NPROJ, C.G, (int)blockIdx.x);
        pg8::EpiProj E{C.ws, (const float*)(C.ws + WS_CS)};
        pg8::gemm_phase<pg8::EpiProj, pg8::StaticOrder, true, true>(lds, g, S, E);
        SEAM(1);
    }
    if (IN(2)) { p2_token_local(C, lds); SEAM(2); }
    if (IN(3)) { p3_indexer(C, lds); }
    if (IN(4)) { if (P4_MFMA) p4_mixer_a_mfma(C, lds); else p4_mixer_a(C); SEAM(4); }
    if (IN(5)) { if (P5_MFMA) p5_mixer_b_mfma(C, lds); else p5_mixer_b(C, lds); SEAM(5); }
    if (IN(6)) {
        pg8::Gemm g{(const pg8::bf16_t*)(C.ws + WS_Y), (const pg8::bf16_t*)(C.ws + WS_WOUT), M, DM, DM}; pg8::StaticOrder S; S.init(M, DM, C.G, (int)blockIdx.x);
        pg8::EpiOut E{C.x, C.out, (const float*)(C.ws + WS_SSA)};
        pg8::gemm_phase<pg8::EpiOut, pg8::StaticOrder, true, true>(lds, g, S, E);
        SEAM(6);
    }
    if (IN(7)) { p7_final_norm(C); }
#undef IN
#undef SEAM
}

extern "C" void kernel_launch(void* const* d_in, const int* in_sizes, int n_in, void* d_out, int out_size, void* d_ws, size_t ws_size, hipStream_t stream) {
    static int grid = 0;
    if (grid == 0) {
        if (n_in != 12 || in_sizes[0] != M * DM || out_size != M * DM || ws_size < WS_END) { fprintf(stderr, "kernel_launch: unexpected shapes (n_in %d, in0 %d, out %d, ws %zu)\n", n_in, n_in > 0 ? in_sizes[0] : -1, out_size, ws_size); grid = -1; return; }
        int dev = 0, cus = 0, per_cu = 0;
        if (hipGetDevice(&dev) != hipSuccess || hipDeviceGetAttribute(&cus, hipDeviceAttributeMultiprocessorCount, dev) != hipSuccess) { grid = -1; return; }
        if (hipFuncSetAttribute((const void*)mk_fwd, hipFuncAttributeMaxDynamicSharedMemorySize, LDS_BYTES) != hipSuccess) { fprintf(stderr, "kernel_launch: hipFuncSetAttribute failed\n"); grid = -1; return; }
        if (hipOccupancyMaxActiveBlocksPerMultiprocessor(&per_cu, (const void*)mk_fwd, NWAVES * 64, LDS_BYTES) != hipSuccess || per_cu < 1) fprintf(stderr, "kernel_launch: occupancy query reports %d\n", per_cu);
        (void)hipGetLastError();
        grid = cus;
    }
    if (grid < 0) return;
    if (hipMemsetAsync((char*)d_ws + WS_CTL, 0, CTL_ZERO_BYTES, stream) != hipSuccess) return;
    Args a{};
    for (int i = 0; i < 12; ++i) a.in[i] = d_in[i];
    a.out = (float*)d_out; a.ws = (unsigned char*)d_ws;
    for (int li = 0; li < N_LAUNCHES; ++li) {
        a.ph_lo = (N_LAUNCHES == 1) ? 0 : li; a.ph_hi = (N_LAUNCHES == 1) ? N_PHASES : li + 1; a.li = li;
        hipLaunchKernelGGL(mk_fwd, dim3(grid), dim3(NWAVES * 64), LDS_BYTES, stream, a);
        const hipError_t le = hipPeekAtLastError();
        if (le != hipSuccess) { fprintf(stderr, "kernel_launch: launch %d failed: %s\n", li, hipGetErrorName(le)); break; }
    }
}
```

```cpp
#include <hip/hip_runtime.h>
#include <cstdio>
#include <cstdint>
namespace pg8 {
#define PG8_LAS __attribute__((address_space(3)))
typedef unsigned short bf16_t;
typedef short bf16x8 __attribute__((ext_vector_type(8)));
typedef float f32x4 __attribute__((ext_vector_type(4)));
typedef unsigned u32x4 __attribute__((ext_vector_type(4)));
constexpr int BM = 256, BK = 64, HALF = 128, HTB = HALF * BK * 2  , STAGE_BYTES = 8 * HTB, NXCD = 8, WGM = 8;

__host__ __device__ __forceinline__ int lds_byte(int r, int c) { const int st = (r >> 4) * 2 + (c >> 5), rr = r & 15, cc = c & 31, ob = rr * 64 + cc * 2; return st * 1024 + (ob ^ (((ob >> 9) & 1) << 5)); }
__host__ __device__ __forceinline__ void stage_rc(int b, int& R, int& C) { const int st = b / 1024, sb = b % 1024, swz = sb ^ (((sb >> 9) & 1) << 5); R = (st >> 1) * 16 + swz / 64; C = (st & 1) * 32 + (swz % 64) / 2; }
__host__ __device__ __forceinline__ int perm32(int rho) { const int n = rho >> 4, i = rho & 15; return 8 * (i >> 2) + 4 * n + (i & 3); }

struct Unit { int pm, pn; };
struct Gemm { const bf16_t* A; const bf16_t* Bt; int M, N, K; };

struct StaticOrder {
    int nM, nN, nwg, G, c;
    __host__ __device__ void init(int M, int N, int G_, int c_) { nM = M / BM; nN = N / BM; nwg = nM * nN; G = G_; c = c_; }
    __host__ __device__ bool next(int i, Unit& u) const {
        const long L = (long)i * G + c; if (L >= nwg) return false;
        int wgid = (int)L; { const int q = nwg / NXCD, r = nwg % NXCD, xcd = wgid % NXCD, off = wgid / NXCD; wgid = (xcd < r ? xcd * (q + 1) : r * (q + 1) + (xcd - r) * q) + off; }
        const int nig = WGM * nN, gid = wgid / nig, fm = gid * WGM, gsz = (nM - fm) < WGM ? (nM - fm) : WGM;
        u.pm = fm + ((wgid % nig) % gsz); u.pn = (wgid % nig) / gsz; return true;
    }
    __device__ __forceinline__ void a_ready(const Unit&) const {}
    __device__ __forceinline__ void done(const Unit&) const {}
};

template <class Epi, class Sched, bool ALIGN_EPI = false, bool SP2 = false>
__device__ __forceinline__ void gemm_phase(PG8_LAS unsigned char* lds, const Gemm g, const Sched& S, const Epi& E) {
    const int tid = threadIdx.x, wid = __builtin_amdgcn_readfirstlane(tid >> 6), lane = tid & 63, wr = wid >> 2, wc = wid & 3, fr = lane & 15, fq = lane >> 4;
    const int K = g.K, nt = K / BK;
    unsigned voffA[2], voffB[2];
#pragma unroll
    for (int i = 0; i < 2; ++i) { int R, C; stage_rc(tid * 16 + i * 8192, R, C); const int Rb = Epi::PERM ? ((R & ~31) + perm32(R & 31)) : R;
        voffA[i] = (unsigned)(R * K + C) * 2u; voffB[i] = (unsigned)(Rb * K + C) * 2u; }
    const size_t kstep = (size_t)(BK * 2);
    const size_t hstep = (size_t)HALF * K * 2;
    const size_t tstep = 2 * hstep;
    const unsigned ldsw = (unsigned)wid * 1024u;
    const int aoff = lds_byte(wr * 64 + fr, fq * 8), boff = lds_byte(wc * 32 + fr, fq * 8);
#define PG8_SA(b, h) (((b) * 2 + (h)) * HTB)
#define PG8_SB(b, h) ((4 + (b) * 2 + (h)) * HTB)
#define PG8_STAGE(bufoff, gbase, voff) do { _Pragma("unroll") for (int _i = 0; _i < 2; ++_i) \
        __builtin_amdgcn_global_load_lds((const unsigned*)((const char*)(gbase) + (voff)[_i]), (PG8_LAS unsigned*)(lds + (bufoff) + ldsw + _i * 8192), 16, 0, 0); } while (0)
#define PG8_LDA(dst, b, h) do { _Pragma("unroll") for (int m = 0; m < 4; ++m) _Pragma("unroll") for (int k = 0; k < 2; ++k) dst[m][k] = *(const PG8_LAS bf16x8*)(lds + PG8_SA(b, h) + aoff + m * 2048 + k * 1024); } while (0)
#define PG8_LDB(dst, b, h) do { _Pragma("unroll") for (int n = 0; n < 2; ++n) _Pragma("unroll") for (int k = 0; k < 2; ++k) dst[n][k] = *(const PG8_LAS bf16x8*)(lds + PG8_SB(b, h) + boff + n * 2048 + k * 1024); } while (0)
#define PG8_MMA(ai, bj, At, Bt) do { __builtin_amdgcn_s_setprio(1); _Pragma("unroll") for (int m = 0; m < 4; ++m) _Pragma("unroll") for (int n = 0; n < 2; ++n) _Pragma("unroll") for (int k = 0; k < 2; ++k) \
        acc[ai][bj][m][n] = __builtin_amdgcn_mfma_f32_16x16x32_bf16(Bt[n][k], At[m][k], acc[ai][bj][m][n], 0, 0, 0); __builtin_amdgcn_s_setprio(0); } while (0)
#define PG8_WAIT_V(n) asm volatile("s_waitcnt vmcnt(" #n ")" ::: "memory")
#define PG8_WAIT_L(n) asm volatile("s_waitcnt lgkmcnt(" #n ")" ::: "memory")
#define PG8_BAR __builtin_amdgcn_s_barrier()
#define PG8_SCHED __builtin_amdgcn_sched_barrier(0)
    Unit cur, nxt; int ui = 0;
    if (!S.next(0, cur)) return;
    f32x4 acc[2][2][4][2];
#pragma unroll
    for (int a = 0; a < 2; ++a)
#pragma unroll
        for (int b = 0; b < 2; ++b)
#pragma unroll
            for (int m = 0; m < 4; ++m)
#pragma unroll
                for (int n = 0; n < 2; ++n) acc[a][b][m][n] = (f32x4){0.f, 0.f, 0.f, 0.f};
    bf16x8 At[4][2], B0[2][2], B1[2][2];
    const char* cA = (const char*)g.A + (size_t)cur.pm * tstep; const char* cB = (const char*)g.Bt + (size_t)cur.pn * tstep;
    S.a_ready(cur);
    if constexpr (SP2) {
        PG8_STAGE(PG8_SB(0, 0), cB, voffB); PG8_STAGE(PG8_SB(0, 1), cB + hstep, voffB); PG8_STAGE(PG8_SA(0, 0), cA, voffA); PG8_STAGE(PG8_SA(0, 1), cA + hstep, voffA);
        if (wr == 1) PG8_BAR;
        PG8_WAIT_V(2); PG8_BAR;
        PG8_STAGE(PG8_SB(1, 0), cB + kstep, voffB); PG8_STAGE(PG8_SA(1, 0), cA + kstep, voffA); PG8_STAGE(PG8_SB(1, 1), cB + hstep + kstep, voffB);
        PG8_WAIT_V(6); PG8_BAR;
    } else {
        PG8_STAGE(PG8_SB(0, 0), cB, voffB); PG8_STAGE(PG8_SA(0, 0), cA, voffA); PG8_STAGE(PG8_SB(0, 1), cB + hstep, voffB); PG8_STAGE(PG8_SA(0, 1), cA + hstep, voffA);
        if (wr == 1) PG8_BAR;
        PG8_WAIT_V(4); PG8_BAR;
        PG8_STAGE(PG8_SB(1, 0), cB + kstep, voffB); PG8_STAGE(PG8_SA(1, 0), cA + kstep, voffA); PG8_STAGE(PG8_SB(1, 1), cB + hstep + kstep, voffB);
        PG8_WAIT_V(6); PG8_BAR;
    }
    for (;;) {
        const bool has_next = S.next(ui + 1, nxt);
        const char* nA = has_next ? (const char*)g.A + (size_t)nxt.pm * tstep : cA; const char* nB = has_next ? (const char*)g.Bt + (size_t)nxt.pn * tstep : cB;
        for (int t = 0; t < nt; t += 2) {
            const bool last = (t == nt - 2);
            const char* a1 = cA + (size_t)(t + 1) * kstep;
            const char* a2 = last ? nA : cA + (size_t)(t + 2) * kstep; const char* b2 = last ? nB : cB + (size_t)(t + 2) * kstep;
            const char* a3 = a2 + kstep; const char* b3 = b2 + kstep;
            if (last && has_next) S.a_ready(nxt);
            if constexpr (SP2) {
            PG8_LDB(B0, 0, 0); PG8_LDB(B1, 0, 1); PG8_SCHED; PG8_LDA(At, 0, 0); PG8_STAGE(PG8_SA(1, 1), a1 + hstep, voffA);
            PG8_WAIT_V(8); PG8_WAIT_L(0); PG8_BAR; PG8_MMA(0, 0, At, B0); PG8_MMA(0, 1, At, B1); PG8_BAR; PG8_SCHED;
            PG8_LDA(At, 0, 1); PG8_STAGE(PG8_SB(0, 0), b2, voffB); PG8_STAGE(PG8_SB(0, 1), b2 + hstep, voffB); PG8_STAGE(PG8_SA(0, 0), a2, voffA);
            PG8_WAIT_V(8); PG8_WAIT_L(0); PG8_BAR; PG8_MMA(1, 0, At, B0); PG8_MMA(1, 1, At, B1); PG8_BAR; PG8_SCHED;
            PG8_LDB(B0, 1, 0); PG8_LDB(B1, 1, 1); PG8_SCHED; PG8_LDA(At, 1, 0); PG8_STAGE(PG8_SA(0, 1), a2 + hstep, voffA);
            PG8_WAIT_V(8); PG8_WAIT_L(0); PG8_BAR; PG8_MMA(0, 0, At, B0); PG8_MMA(0, 1, At, B1); PG8_BAR; PG8_SCHED;
            PG8_LDA(At, 1, 1); PG8_STAGE(PG8_SB(1, 0), b3, voffB); PG8_STAGE(PG8_SB(1, 1), b3 + hstep, voffB); PG8_STAGE(PG8_SA(1, 0), a3, voffA);
            PG8_WAIT_V(8); PG8_WAIT_L(0); PG8_BAR; PG8_MMA(1, 0, At, B0); PG8_MMA(1, 1, At, B1); PG8_BAR; PG8_SCHED;
            } else {
            PG8_LDB(B0, 0, 0); PG8_SCHED; PG8_LDA(At, 0, 0); PG8_STAGE(PG8_SA(1, 1), a1 + hstep, voffA);
            PG8_WAIT_L(8); PG8_BAR; PG8_WAIT_L(0); PG8_MMA(0, 0, At, B0); PG8_BAR; PG8_SCHED;
            PG8_LDB(B1, 0, 1); PG8_STAGE(PG8_SB(0, 0), b2, voffB);
            PG8_BAR; PG8_WAIT_L(0); PG8_MMA(0, 1, At, B1); PG8_BAR;
            PG8_LDA(At, 0, 1); PG8_STAGE(PG8_SA(0, 0), a2, voffA);
            PG8_BAR; PG8_WAIT_L(0); PG8_MMA(1, 0, At, B0); PG8_BAR; PG8_SCHED;
            PG8_STAGE(PG8_SB(0, 1), b2 + hstep, voffB);
            PG8_WAIT_V(6); PG8_BAR; PG8_MMA(1, 1, At, B1); PG8_BAR;
            PG8_LDB(B0, 1, 0); PG8_SCHED; PG8_LDA(At, 1, 0); PG8_STAGE(PG8_SA(0, 1), a2 + hstep, voffA);
            PG8_WAIT_L(8); PG8_BAR; PG8_WAIT_L(0); PG8_MMA(0, 0, At, B0); PG8_BAR; PG8_SCHED;
            PG8_LDB(B1, 1, 1); PG8_STAGE(PG8_SB(1, 0), b3, voffB);
            PG8_BAR; PG8_WAIT_L(0); PG8_MMA(0, 1, At, B1); PG8_BAR;
            PG8_LDA(At, 1, 1); PG8_STAGE(PG8_SA(1, 0), a3, voffA);
            PG8_BAR; PG8_WAIT_L(0); PG8_MMA(1, 0, At, B0); PG8_BAR; PG8_SCHED;
            PG8_STAGE(PG8_SB(1, 1), b3 + hstep, voffB);
            PG8_WAIT_V(6); PG8_BAR; PG8_MMA(1, 1, At, B1); PG8_BAR;
            }
        }
        if constexpr (ALIGN_EPI) { if (wr == 0) PG8_BAR; }
        if constexpr (!Epi::AFTER_DRAIN) { E(acc, cur, wr, wc, fr, fq); S.done(cur); }
        if (!has_next) break;
#pragma unroll
        for (int a = 0; a < 2; ++a)
#pragma unroll
            for (int b = 0; b < 2; ++b)
#pragma unroll
                for (int m = 0; m < 4; ++m)
#pragma unroll
                    for (int n = 0; n < 2; ++n) acc[a][b][m][n] = (f32x4){0.f, 0.f, 0.f, 0.f};
        cur = nxt; cA = nA; cB = nB; ++ui;
        if constexpr (ALIGN_EPI) { if (wr == 1) PG8_BAR; }
    }
    PG8_WAIT_V(0);
    if constexpr (!ALIGN_EPI) { if (wr == 0) PG8_BAR; }
    PG8_BAR;
    if constexpr (Epi::AFTER_DRAIN) { E.fused(acc, cur, wr, wc, fr, fq, lds, wid, lane); S.done(cur); }
#undef PG8_SA
#undef PG8_SB
#undef PG8_STAGE
#undef PG8_LDA
#undef PG8_LDB
#undef PG8_MMA
#undef PG8_WAIT_V
#undef PG8_WAIT_L
#undef PG8_BAR
#undef PG8_SCHED
}
}

#ifndef MK_N_LAUNCHES
#define MK_N_LAUNCHES 1
#endif
constexpr int N_LAUNCHES = MK_N_LAUNCHES;
constexpr int N_PHASES = 8;

constexpr int NWAVES = 8;
constexpr int BATCH = 16, SEQ = 2048, DM = 1024, M = BATCH * SEQ;
constexpr int DIN = 3524, NPROJ = 3584;
constexpr float EPS = 1e-6f;
constexpr float C2 = 0.125f * 1.4426950408889634f;

constexpr size_t MiB = 1u << 20;
constexpr size_t WS_CTL = 0, CTL_ZERO_BYTES = 1 * MiB;
constexpr size_t WS_WIN = 2 * MiB;
constexpr size_t WS_WOUT = 10 * MiB;
constexpr size_t WS_CS = 12 * MiB;
constexpr size_t WS_SSA = 14 * MiB;
constexpr size_t WS_XN = 16 * MiB;
constexpr size_t WS_Y = WS_XN;
constexpr size_t WS_QA = 80 * MiB;
constexpr size_t WS_KA = WS_QA + 32 * MiB, WS_VA = WS_QA + 64 * MiB, WS_ZA = WS_QA + 96 * MiB, WS_QB = WS_QA + 128 * MiB, WS_ZB = WS_QA + 160 * MiB;
constexpr size_t WS_IQ = 272 * MiB;
constexpr size_t WS_MISC = 288 * MiB;
constexpr size_t WS_KB = 320 * MiB;
constexpr size_t WS_VB = 324 * MiB;
constexpr size_t WS_IKN = 356 * MiB;
constexpr size_t WS_IW = 364 * MiB;
constexpr size_t WS_MASK = 366 * MiB;
constexpr size_t WS_END = 376 * MiB;
constexpr int CW_BAR = 4096;

constexpr int LDS_BYTES = 155648;
constexpr int LDSCTL_OFF = LDS_BYTES - 256;

#define GAS __attribute__((address_space(1)))
#define LAS __attribute__((address_space(3)))
typedef unsigned short bf16;
typedef unsigned v4u __attribute__((ext_vector_type(4)));
typedef float f32x4 __attribute__((ext_vector_type(4)));
typedef GAS unsigned gu32;
#define RLX_AGENT __ATOMIC_RELAXED, __HIP_MEMORY_SCOPE_AGENT
__device__ __forceinline__ unsigned f2bf(float f) { unsigned u = __builtin_bit_cast(unsigned, f); return (u + 0x7fffu + ((u >> 16) & 1u)) >> 16; }
__device__ __forceinline__ unsigned pk2(float lo, float hi) { return f2bf(lo) | (f2bf(hi) << 16); }
__device__ __forceinline__ float bf2f(unsigned short h) { return __builtin_bit_cast(float, (unsigned)h << 16); }
__device__ __forceinline__ float bflo(unsigned w) { return __builtin_bit_cast(float, w << 16); }
__device__ __forceinline__ float bfhi(unsigned w) { return __builtin_bit_cast(float, w & 0xffff0000u); }
__device__ __forceinline__ float wave_sum(float v) {
#pragma unroll
    for (int o = 1; o < 64; o <<= 1) v += __shfl_xor(v, o);
    return v;
}
__device__ __forceinline__ float wave_max(float v) {
#pragma unroll
    for (int o = 1; o < 64; o <<= 1) v = fmaxf(v, __shfl_xor(v, o));
    return v;
}

#define XB_TMO      128
#define XB_XCNT(j)  (256  + 64 * (j))
#define XB_XSUB(j)  (1280 + 64 * (j))
#define XB_XGEN(j)  (2304 + 64 * (j))
#define XB_TOP      3328
#define XB_TOPGEN   3392
#define XCD_BAR_WORDS 3456
#define XB_SPIN_CAP (1u << 18)

__device__ __forceinline__ unsigned xb_ld(unsigned* p)              { return __hip_atomic_load(p, __ATOMIC_RELAXED, __HIP_MEMORY_SCOPE_AGENT); }
__device__ __forceinline__ unsigned xb_add(unsigned* p, unsigned v) { return __hip_atomic_fetch_add(p, v, __ATOMIC_RELAXED, __HIP_MEMORY_SCOPE_AGENT); }
__device__ __forceinline__ unsigned xb_xcc_id() { return (unsigned)__builtin_amdgcn_s_getreg((3 << 11) | 20) & 0xFu; }
#define XB_SPIN(cond, bar) do { unsigned _sp = 0; while (cond) { __builtin_amdgcn_s_sleep(1); \
    if ((++_sp & 255u) == 0u) { if (xb_ld(&(bar)[XB_TMO])) break; if (_sp > XB_SPIN_CAP) { atomicAdd(&(bar)[XB_TMO], 1u); break; } } } } while (0)

struct XcdBarrier {
    unsigned* bar; unsigned x;
    volatile LAS unsigned* st;
};

__device__ __forceinline__ XcdBarrier xcd_barrier_post(unsigned* bar, volatile LAS unsigned* st) {
    XcdBarrier b; b.bar = bar; b.x = xb_xcc_id(); b.st = st;
    if (threadIdx.x == 0) (void)xb_add(&bar[XB_XCNT(b.x)], 1u);
    return b;
}
__device__ __forceinline__ void xcd_barrier_complete(unsigned* bar, unsigned x, unsigned& nloc, unsigned& nx) {
    const unsigned G = gridDim.x * gridDim.y * gridDim.z;
    unsigned sum, cnt, mine, sp = 0u;
    for (;;) {
        sum = 0u; cnt = 0u; mine = 0u;
#pragma unroll
        for (unsigned j = 0; j < 16; ++j) { const unsigned c = xb_ld(&bar[XB_XCNT(j)]); sum += c; cnt += (c > 0u) ? 1u : 0u; mine = (j == x) ? c : mine; }
        if (sum == G) break;
        __builtin_amdgcn_s_sleep(1);
        if ((++sp & 255u) == 0u) { if (xb_ld(&bar[XB_TMO])) break; if (sp > XB_SPIN_CAP) { atomicAdd(&bar[XB_TMO], 1u); break; } }
    }
    nloc = mine > 0u ? mine : 1u; nx = cnt > 0u ? cnt : 1u;
}

__device__ __forceinline__ void xcd_barrier(const XcdBarrier& b) {
    asm volatile("s_waitcnt vmcnt(0)" ::: "memory");
    __syncthreads();
    if (threadIdx.x == 0) {
        unsigned* bar = b.bar;
        __builtin_amdgcn_s_waitcnt(0);
        unsigned nloc = b.st[0], nx = b.st[1];
        if (nloc == 0u) { xcd_barrier_complete(bar, b.x, nloc, nx); b.st[0] = nloc; b.st[1] = nx; }
        const unsigned old = xb_add(&bar[XB_XSUB(b.x)], 1u);
        const unsigned gen = old / nloc;
        if (old + 1u == (gen + 1u) * nloc) {
            __builtin_amdgcn_fence(__ATOMIC_RELEASE, "agent");
            asm volatile("s_waitcnt vmcnt(0)" ::: "memory");
            const unsigned og = xb_add(&bar[XB_TOP], 1u);
            const unsigned tg = og / nx;
            if (og + 1u == (tg + 1u) * nx) xb_add(&bar[XB_TOPGEN], 1u);
            else XB_SPIN(xb_ld(&bar[XB_TOPGEN]) == tg, bar);
            __builtin_amdgcn_fence(__ATOMIC_ACQUIRE, "agent");
            xb_add(&bar[XB_XGEN(b.x)], 1u);
            asm volatile("s_waitcnt vmcnt(0)" ::: "memory");
        } else {
            XB_SPIN(xb_ld(&bar[XB_XGEN(b.x)]) == gen, bar);
            __builtin_amdgcn_fence(__ATOMIC_ACQUIRE, "agent");
            asm volatile("s_waitcnt vmcnt(0)" ::: "memory");
        }
    }
    __syncthreads();
}


struct Ctx {
    const float* x; const int* pos; const float* g_in; const float* w_in; const float* g_kv; const float* w_uk; const float* w_uv; const float* g_ik;
    const float* g_a; const float* g_b; const float* w_out; const float* g_fin;
    float* out; unsigned char* ws;
    int tid, lane, wave, G, gw, NGW;
};

namespace pg8 {
__device__ __forceinline__ unsigned cvt_pk_bf16(float lo, float hi) { unsigned r; asm volatile("v_cvt_pk_bf16_f32 %0, %1, %2" : "=v"(r) : "v"(lo), "v"(hi)); return r; }
struct EpiProj {
    static constexpr bool PERM = true, AFTER_DRAIN = false;
    unsigned char* ws; const float* cs;
    __device__ __forceinline__ void operator()(const f32x4 (&acc)[2][2][4][2], const Unit& u, int wr, int wc, int fr, int fq) const {
        const int pn = u.pn;
        const int row0 = u.pm * BM + wr * 64 + fr;
        if (pn == 13) {
            float* base = (float*)(ws + WS_MISC) + wc * 32 + 8 * fq;
#pragma unroll
            for (int ai = 0; ai < 2; ++ai)
#pragma unroll
                for (int m = 0; m < 4; ++m) { float* rowp = base + (size_t)(row0 + ai * HALF + m * 16) * 256;
#pragma unroll
                    for (int bj = 0; bj < 2; ++bj) { *(f32x4*)(rowp + bj * HALF) = acc[ai][bj][m][0]; *(f32x4*)(rowp + bj * HALF + 4) = acc[ai][bj][m][1]; } }
            return;
        }
        bf16_t* base; int ld;
        if (pn == 12) { base = (bf16_t*)(ws + WS_IQ); ld = 256; }
        else { base = (bf16_t*)(ws + WS_QA + (size_t)(pn >> 1) * (32 * MiB)) + (pn & 1) * 256; ld = 512; }
        const bool rope = (pn < 4) || (pn == 8) || (pn == 9) || (pn == 12);
        const float sc = (pn < 2 || pn == 8 || pn == 9) ? C2 : 1.0f;
        const bool ropew = rope && ((wc & 1) == 0);
        base += wc * 32 + 8 * fq;
#pragma unroll
        for (int ai = 0; ai < 2; ++ai)
#pragma unroll
            for (int m = 0; m < 4; ++m) {
                const int row = row0 + ai * HALF + m * 16;
                bf16_t* rowp = base + (size_t)row * ld;
                f32x4 c0 = {1.f, 1.f, 1.f, 1.f}, c1 = c0, s0 = {0.f, 0.f, 0.f, 0.f}, s1 = s0;
                if (ropew) { const f32x4* cp = (const f32x4*)(cs + (size_t)row * 16); c0 = cp[0]; c1 = cp[1]; s0 = cp[2]; s1 = cp[3]; if (fq == 0) { s0 = -s0; s1 = -s1; } if (fq >= 2) { c0 = (f32x4){1.f, 1.f, 1.f, 1.f}; c1 = c0; s0 = (f32x4){0.f, 0.f, 0.f, 0.f}; s1 = s0; } }
#pragma unroll
                for (int bj = 0; bj < 2; ++bj) {
                    f32x4 v0 = acc[ai][bj][m][0], v1 = acc[ai][bj][m][1];
                    if (ropew) {
                        f32x4 p0, p1;
#pragma unroll
                        for (int e = 0; e < 4; ++e) { p0[e] = __shfl_xor(v0[e], 16); p1[e] = __shfl_xor(v1[e], 16); }
                        v0 = v0 * c0 + p0 * s0; v1 = v1 * c1 + p1 * s1;
                    }
                    v0 = v0 * sc; v1 = v1 * sc;
                    u32x4 w; w.x = cvt_pk_bf16(v0[0], v0[1]); w.y = cvt_pk_bf16(v0[2], v0[3]); w.z = cvt_pk_bf16(v1[0], v1[1]); w.w = cvt_pk_bf16(v1[2], v1[3]);
                    *(u32x4*)(rowp + bj * HALF) = w;
                }
            }
    }
};
struct EpiOut {
    static constexpr bool PERM = false, AFTER_DRAIN = false;
    const float* x; float* out; const float* ssa;
    __device__ __forceinline__ void operator()(const f32x4 (&acc)[2][2][4][2], const Unit& u, int wr, int wc, int fr, int fq) const {
        const int col0 = u.pn * BM + wc * 32 + 4 * fq;
#pragma unroll
        for (int ai = 0; ai < 2; ++ai)
#pragma unroll
            for (int m = 0; m < 4; ++m) {
                const int r = u.pm * BM + ai * HALF + wr * 64 + m * 16 + fr;
                const f32x4 a0 = *(const f32x4*)(ssa + (size_t)r * 8), a1 = *(const f32x4*)(ssa + (size_t)r * 8 + 4);
                const float ss = ((a0[0] + a0[1]) + (a0[2] + a0[3])) + ((a1[0] + a1[1]) + (a1[2] + a1[3]));
                const float rs = 1.0f / sqrtf(ss * (1.0f / 512.0f) + EPS);
                const size_t off = (size_t)r * DM + col0;
#pragma unroll
                for (int bj = 0; bj < 2; ++bj)
#pragma unroll
                    for (int n = 0; n < 2; ++n) { const f32x4 xv = *(const f32x4*)(x + off + bj * HALF + n * 16); *(f32x4*)(out + off + bj * HALF + n * 16) = xv + acc[ai][bj][m][n] * rs; }
            }
    }
};
}

__device__ __forceinline__ void p0_transpose_item(const float* W, int ldw, int srccol0, int nvalid, const float* rowgain, bf16* WT, int K, int n0, int k0, LAS float* scr, int lane) {
#pragma unroll 8
    for (int i = 0; i < 32; ++i) { const int kk = 2 * i + (lane >> 5), n = lane & 31; float v = 0.f; if (n < nvalid) { v = W[(size_t)(k0 + kk) * ldw + srccol0 + n]; if (rowgain) v *= rowgain[k0 + kk]; } scr[kk * 33 + n] = v; }
    asm volatile("s_waitcnt lgkmcnt(0)" ::: "memory");
    const int c = lane & 7;
#pragma unroll
    for (int j = 0; j < 4; ++j) { const int n = (lane >> 3) + 8 * j; const LAS float* s = scr + (8 * c) * 33 + n;
        v4u o; o.x = pk2(s[0 * 33], s[1 * 33]); o.y = pk2(s[2 * 33], s[3 * 33]); o.z = pk2(s[4 * 33], s[5 * 33]); o.w = pk2(s[6 * 33], s[7 * 33]);
        *(GAS v4u*)(WT + (size_t)(n0 + n) * K + k0 + 8 * c) = o; }
    asm volatile("s_waitcnt lgkmcnt(0)" ::: "memory");
}
__device__ __forceinline__ void p0_prologue(const Ctx& C, LAS unsigned char* lds) {
    LAS float* scr = (LAS float*)(lds + C.wave * 16384);
    constexpr int I1 = 16 * (NPROJ / 32), I2 = 16 * (DM / 32);
    for (int it = C.gw; it < I1 + I2; it += C.NGW) {
        if (it < I1) {
            const int kb = it / (NPROJ / 32), nb = it % (NPROJ / 32), n0 = 32 * nb;
            int src;
            if (n0 < 2560) src = n0; else if (n0 < 3072) src = 2688 + (n0 - 2560); else if (n0 < 3328) src = 3200 + (n0 - 3072); else if (n0 < 3456) src = 2560 + (n0 - 3328); else src = n0;
            const int nvalid = (n0 + 32 <= DIN) ? 32 : (n0 < DIN ? DIN - n0 : 0);
            p0_transpose_item(C.w_in, DIN, src, nvalid, nullptr, (bf16*)(C.ws + WS_WIN), DM, n0, 64 * kb, scr, C.lane);
        } else {
            const int r = it - I1, kb = r / (DM / 32), nb = r % (DM / 32);
            const float* gain = (kb < 8) ? C.g_a : (C.g_b - 512);
            p0_transpose_item(C.w_out, DM, 32 * nb, 32, gain, (bf16*)(C.ws + WS_WOUT), DM, 32 * nb, 64 * kb, scr, C.lane);
        }
    }
    for (int m = C.gw; m < M; m += C.NGW) {
        const GAS f32x4* xr = (const GAS f32x4*)(C.x + (size_t)m * DM) + C.lane;
        const GAS f32x4* gr = (const GAS f32x4*)C.g_in + C.lane;
        f32x4 v[4]; float s = 0.f;
#pragma unroll
        for (int j = 0; j < 4; ++j) { v[j] = xr[64 * j]; s += (v[j].x * v[j].x + v[j].y * v[j].y) + (v[j].z * v[j].z + v[j].w * v[j].w); }
        const float rs = 1.0f / sqrtf(wave_sum(s) * (1.0f / DM) + EPS);
        GAS unsigned long long* o8 = (GAS unsigned long long*)((bf16*)(C.ws + WS_XN) + (size_t)m * DM) + C.lane;
#pragma unroll
        for (int j = 0; j < 4; ++j) { const f32x4 g = gr[64 * j]; o8[64 * j] = (unsigned long long)pk2(v[j].x * rs * g.x, v[j].y * rs * g.y) | ((unsigned long long)pk2(v[j].z * rs * g.z, v[j].w * rs * g.w) << 32); }
    }
    for (int e = blockIdx.x * (NWAVES * 64) + C.tid; e < M * 8; e += C.G * NWAVES * 64) {
        const int tok = e >> 3, j = e & 7;
        const float inv = exp2f(-(float)j * (18.931568569324174f / 8.0f));
        const float ang = (float)C.pos[tok] * inv;
        const double rev = (double)ang * 0.15915494309189535;
        const float fr = (float)(rev - rint(rev));
        float* cs = (float*)(C.ws + WS_CS) + (size_t)tok * 16;
        cs[j] = __builtin_amdgcn_cosf(fr); cs[8 + j] = __builtin_amdgcn_sinf(fr);
    }
}

__device__ __forceinline__ void p2_token_local(const Ctx& C, LAS unsigned char* lds) {
    LAS float* ck = (LAS float*)(lds + C.wave * 16384);
    const int lane = C.lane;
    const float* misc = (const float*)(C.ws + WS_MISC);
    const float* cs = (const float*)(C.ws + WS_CS);
    for (int grp = C.gw; grp < M / 8; grp += C.NGW) {
        const int tok0 = grp * 8;
#pragma unroll 1
        for (int tt = 0; tt < 8; ++tt) {
            const int tok = tok0 + tt; const float* mr = misc + (size_t)tok * 256;
            const float a = mr[2 * lane], b = mr[2 * lane + 1];
            const float rs = 1.0f / sqrtf(wave_sum(a * a + b * b) * (1.0f / 128.0f) + EPS);
            ck[tt * 128 + 2 * lane] = a * rs * C.g_kv[2 * lane]; ck[tt * 128 + 2 * lane + 1] = b * rs * C.g_kv[2 * lane + 1];
            const float k = mr[128 + lane];
            const float rk = 1.0f / sqrtf(wave_sum(k * k) * (1.0f / 64.0f) + EPS);
            float kn = k * rk * C.g_ik[lane];
            const float partner = __shfl_xor(kn, 8);
            if (lane < 16) { const float c = cs[(size_t)tok * 16 + (lane & 7)], s = cs[(size_t)tok * 16 + 8 + (lane & 7)]; kn = (lane < 8) ? kn * c - partner * s : kn * c + partner * s; }
            ((bf16*)(C.ws + WS_IKN))[(size_t)tok * 64 + lane] = (bf16)f2bf(kn);
            if (lane < 4) ((float*)(C.ws + WS_IW))[(size_t)tok * 4 + lane] = mr[192 + lane] * 0.0625f;
        }
        asm volatile("s_waitcnt lgkmcnt(0)" ::: "memory");
        float acc[9][8];
#pragma unroll
        for (int i = 0; i < 9; ++i)
#pragma unroll
            for (int t = 0; t < 8; ++t) acc[i][t] = 0.f;
#pragma unroll 2
        for (int c = 0; c < 128; ++c) {
            float w[9]; w[0] = C.w_uk[c * 64 + lane];
#pragma unroll
            for (int h = 0; h < 8; ++h) w[1 + h] = C.w_uv[(size_t)(h * 128 + c) * 64 + lane];
#pragma unroll
            for (int t = 0; t < 8; ++t) { const float a = ck[t * 128 + c];
#pragma unroll
                for (int i = 0; i < 9; ++i) acc[i][t] += a * w[i]; }
        }
#pragma unroll
        for (int t = 0; t < 8; ++t) {
            const int tok = tok0 + t;
            float kb = acc[0][t];
            const float partner = __shfl_xor(kb, 8);
            if (lane < 16) { const float c = cs[(size_t)tok * 16 + (lane & 7)], s = cs[(size_t)tok * 16 + 8 + (lane & 7)]; kb = (lane < 8) ? kb * c - partner * s : kb * c + partner * s; }
            ((bf16*)(C.ws + WS_KB))[(size_t)tok * 64 + lane] = (bf16)f2bf(kb);
#pragma unroll
            for (int h = 0; h < 8; ++h) ((bf16*)(C.ws + WS_VB))[(size_t)tok * 512 + h * 64 + lane] = (bf16)f2bf(acc[1 + h][t]);
        }
        asm volatile("s_waitcnt lgkmcnt(0)" ::: "memory");
    }
}

__device__ __forceinline__ void select_topk(const LAS float* srow, int t, unsigned long long* maskrow, int lane) {
    unsigned key[32];
#pragma unroll
    for (int j = 0; j < 32; ++j) { const int s = 64 * j + lane; unsigned u = 0u; if (s <= t) { const unsigned f = __float_as_uint(srow[s]); u = (f & 0x80000000u) ? ~f : (f | 0x80000000u); } key[j] = u; }
    const int nregs = (t >> 6) + 1;
    unsigned long long myword = 0ull;
    if (t + 1 <= 256) {
#pragma unroll
        for (int j = 0; j < 32; ++j) { const unsigned long long b = __builtin_amdgcn_ballot_w64(key[j] != 0u); if (lane == j) myword = b; }
    } else {
        unsigned T = 0u; bool exact = false;
        for (int bit = 31; bit >= 0; --bit) {
            const unsigned cand = T | (1u << bit);
            int c = 0;
#pragma unroll
            for (int j = 0; j < 32; ++j) if (j < nregs) c += __builtin_popcountll(__builtin_amdgcn_ballot_w64(key[j] >= cand));
            if (c >= 256) { T = cand; if (c == 256) { exact = true; break; } }
        }
        if (exact) {
#pragma unroll
            for (int j = 0; j < 32; ++j) { const unsigned long long b = __builtin_amdgcn_ballot_w64(key[j] >= T); if (lane == j) myword = b; }
        } else {
            int cgt = 0;
#pragma unroll
            for (int j = 0; j < 32; ++j) cgt += __builtin_popcountll(__builtin_amdgcn_ballot_w64(key[j] > T));
            const int r = 256 - cgt; int running = 0;
            const unsigned long long ltmask = (1ull << lane) - 1ull;
#pragma unroll
            for (int j = 0; j < 32; ++j) {
                const unsigned long long eq = __builtin_amdgcn_ballot_w64(key[j] == T);
                const int pre = running + __builtin_popcountll(eq & ltmask);
                const bool s = (key[j] > T) || (key[j] == T && pre < r);
                const unsigned long long b = __builtin_amdgcn_ballot_w64(s);
                if (lane == j) myword = b;
                running += __builtin_popcountll(eq);
            }
        }
    }
    if (lane < 32) maskrow[lane] = myword;
}
__device__ __forceinline__ void p3_indexer(const Ctx& C, LAS unsigned char* lds) {
    LAS float* scores = (LAS float*)lds;
    LAS float* iql = (LAS float*)(lds + 131072);
    LAS float* iwl = (LAS float*)(lds + 131072 + 16384);
    const bf16* IQ = (const bf16*)(C.ws + WS_IQ); const bf16* IKN = (const bf16*)(C.ws + WS_IKN); const float* IW = (const float*)(C.ws + WS_IW);
    unsigned long long* MASK = (unsigned long long*)(C.ws + WS_MASK);
    for (int unit = blockIdx.x; unit < BATCH * (SEQ / 16); unit += C.G) {
        const int b = unit / (SEQ / 16), t0 = (unit % (SEQ / 16)) * 16; const size_t tokb = (size_t)b * SEQ;
        {
            const int idx = C.tid * 8; const v4u w = *(const GAS v4u*)(IQ + (tokb + t0 + (idx >> 8)) * 256 + (idx & 255));
            LAS float* d = iql + idx; d[0] = bflo(w.x); d[1] = bfhi(w.x); d[2] = bflo(w.y); d[3] = bfhi(w.y); d[4] = bflo(w.z); d[5] = bfhi(w.z); d[6] = bflo(w.w); d[7] = bfhi(w.w);
            if (C.tid < 64) iwl[C.tid] = IW[(tokb + t0) * 4 + C.tid];
        }
        __syncthreads();
        const int nkeys = t0 + 16;
        for (int s = C.tid; s < nkeys; s += NWAVES * 64) {
            float k[64];
            const GAS v4u* kp = (const GAS v4u*)(IKN + (tokb + s) * 64);
#pragma unroll
            for (int i = 0; i < 8; ++i) { const v4u w = kp[i]; k[8 * i] = bflo(w.x); k[8 * i + 1] = bfhi(w.x); k[8 * i + 2] = bflo(w.y); k[8 * i + 3] = bfhi(w.y); k[8 * i + 4] = bflo(w.z); k[8 * i + 5] = bfhi(w.z); k[8 * i + 6] = bflo(w.w); k[8 * i + 7] = bfhi(w.w); }
#pragma unroll 1
            for (int q = 0; q < 16; ++q) {
                float sc = 0.f;
#pragma unroll
                for (int h = 0; h < 4; ++h) {
                    const LAS f32x4* qp = (const LAS f32x4*)(iql + q * 256 + h * 64);
                    float d0 = 0.f, d1 = 0.f;
#pragma unroll
                    for (int i = 0; i < 16; ++i) { const f32x4 qv = qp[i]; d0 += qv.x * k[4 * i] + qv.z * k[4 * i + 2]; d1 += qv.y * k[4 * i + 1] + qv.w * k[4 * i + 3]; }
                    sc += iwl[q * 4 + h] * fmaxf(d0 + d1, 0.f);
                }
                scores[q * 2048 + s] = sc;
            }
        }
        __syncthreads();
#pragma unroll 1
        for (int qq = 0; qq < 2; ++qq) { const int q = C.wave * 2 + qq, t = t0 + q; select_topk(scores + q * 2048, t, MASK + (tokb + t) * 32, C.lane); }
        __syncthreads();
    }
}

__device__ __forceinline__ void p4_mixer_a(const Ctx& C) {
    const bf16* QA = (const bf16*)(C.ws + WS_QA); const bf16* KA = (const bf16*)(C.ws + WS_KA); const bf16* VA = (const bf16*)(C.ws + WS_VA); const bf16* ZA = (const bf16*)(C.ws + WS_ZA);
    bf16* Y = (bf16*)(C.ws + WS_Y); float* SSA = (float*)(C.ws + WS_SSA);
    const int lane = C.lane;
    for (int job = C.gw; job < M * 8; job += C.NGW) {
        const int tok = job >> 3, h = job & 7, b = tok / SEQ, t = tok % SEQ; const size_t tokb = (size_t)b * SEQ;
        float qf[64];
        { const GAS v4u* qp = (const GAS v4u*)(QA + (size_t)tok * 512 + h * 64);
#pragma unroll
          for (int i = 0; i < 8; ++i) { const v4u w = qp[i]; qf[8 * i] = bflo(w.x); qf[8 * i + 1] = bfhi(w.x); qf[8 * i + 2] = bflo(w.y); qf[8 * i + 3] = bfhi(w.y); qf[8 * i + 4] = bflo(w.z); qf[8 * i + 5] = bfhi(w.z); qf[8 * i + 6] = bflo(w.w); qf[8 * i + 7] = bfhi(w.w); } }
        float sv[7]; int pv[7]; float mx = -INFINITY;
#pragma unroll
        for (int i = 0; i < 7; ++i) {
            const int e = lane + 64 * i; int d, j;
            if (e < 129) { d = 1; j = e; } else if (e < 258) { d = 4; j = e - 129; } else { d = 16; j = e - 258; }
            const int p = t - j * d; const bool valid = (e < 387) && (p >= 0);
            float s = -INFINITY;
            if (valid) { const GAS v4u* kp = (const GAS v4u*)(KA + (tokb + p) * 512 + h * 64); float a0 = 0.f, a1 = 0.f;
#pragma unroll
                for (int c = 0; c < 8; ++c) { const v4u w = kp[c]; a0 += qf[8 * c] * bflo(w.x) + qf[8 * c + 2] * bflo(w.y) + qf[8 * c + 4] * bflo(w.z) + qf[8 * c + 6] * bflo(w.w); a1 += qf[8 * c + 1] * bfhi(w.x) + qf[8 * c + 3] * bfhi(w.y) + qf[8 * c + 5] * bfhi(w.z) + qf[8 * c + 7] * bfhi(w.w); }
                s = a0 + a1; }
            sv[i] = s; pv[i] = valid ? p : 0; mx = fmaxf(mx, s);
        }
        mx = wave_max(mx);
        float lsum = 0.f;
#pragma unroll
        for (int i = 0; i < 7; ++i) { sv[i] = exp2f(sv[i] - mx); lsum += sv[i]; }
        lsum = wave_sum(lsum);
        float o = 0.f;
        const bf16* vcol = VA + tokb * 512 + h * 64 + lane;
#pragma unroll
        for (int i = 0; i < 7; ++i) {
            const int cnt = (i < 6) ? 64 : 3;
#pragma unroll 8
            for (int l2 = 0; l2 < cnt; ++l2) { const float pp = __builtin_bit_cast(float, __builtin_amdgcn_readlane(__builtin_bit_cast(int, sv[i]), l2)); const int ps = __builtin_amdgcn_readlane(pv[i], l2);
                o += pp * bf2f(vcol[(size_t)ps * 512]); }
        }
        o = o / lsum;
        const float z = bf2f(ZA[(size_t)tok * 512 + h * 64 + lane]);
        const float v = o * z / (1.0f + __expf(-z));
        const float ss = wave_sum(v * v);
        if (lane == 0) SSA[(size_t)tok * 8 + h] = ss;
        Y[(size_t)tok * DM + h * 64 + lane] = (bf16)f2bf(v);
    }
}

__device__ __forceinline__ void p5_mixer_b(const Ctx& C, LAS unsigned char* lds) {
    const bf16* QB = (const bf16*)(C.ws + WS_QB); const bf16* KB = (const bf16*)(C.ws + WS_KB); const bf16* VB = (const bf16*)(C.ws + WS_VB); const bf16* ZB = (const bf16*)(C.ws + WS_ZB);
    const unsigned long long* MASK = (const unsigned long long*)(C.ws + WS_MASK);
    bf16* Y = (bf16*)(C.ws + WS_Y); const float* SSA = (const float*)(C.ws + WS_SSA);
    LAS float* red = (LAS float*)lds;
    const int lane = C.lane, h = C.wave;
    for (int tok = blockIdx.x; tok < M; tok += C.G) {
        const int b = tok / SEQ, t = tok % SEQ; const size_t tokb = (size_t)b * SEQ;
        float qf[64];
        { const GAS v4u* qp = (const GAS v4u*)(QB + (size_t)tok * 512 + h * 64);
#pragma unroll
          for (int i = 0; i < 8; ++i) { const v4u w = qp[i]; qf[8 * i] = bflo(w.x); qf[8 * i + 1] = bfhi(w.x); qf[8 * i + 2] = bflo(w.y); qf[8 * i + 3] = bfhi(w.y); qf[8 * i + 4] = bflo(w.z); qf[8 * i + 5] = bfhi(w.z); qf[8 * i + 6] = bflo(w.w); qf[8 * i + 7] = bfhi(w.w); } }
        const int nw = (t >> 6) + 1;
        float sv[32]; float mx = -INFINITY;
#pragma unroll
        for (int j = 0; j < 32; ++j) {
            float s = -INFINITY;
            if (j < nw) {
                const unsigned long long w = MASK[(size_t)tok * 32 + j];
                if ((w >> lane) & 1ull) { const GAS v4u* kp = (const GAS v4u*)(KB + (tokb + 64 * j + lane) * 64); float a0 = 0.f, a1 = 0.f;
#pragma unroll
                    for (int c = 0; c < 8; ++c) { const v4u x = kp[c]; a0 += qf[8 * c] * bflo(x.x) + qf[8 * c + 2] * bflo(x.y) + qf[8 * c + 4] * bflo(x.z) + qf[8 * c + 6] * bflo(x.w); a1 += qf[8 * c + 1] * bfhi(x.x) + qf[8 * c + 3] * bfhi(x.y) + qf[8 * c + 5] * bfhi(x.z) + qf[8 * c + 7] * bfhi(x.w); }
                    s = a0 + a1; }
            }
            sv[j] = s; mx = fmaxf(mx, s);
        }
        mx = wave_max(mx);
        float lsum = 0.f;
#pragma unroll
        for (int j = 0; j < 32; ++j) { sv[j] = exp2f(sv[j] - mx); lsum += sv[j]; }
        lsum = wave_sum(lsum);
        float o = 0.f;
        const bf16* vcol = VB + tokb * 512 + h * 64 + lane;
#pragma unroll
        for (int j = 0; j < 32; ++j) {
            if (j < nw) {
                const unsigned long long wv = MASK[(size_t)tok * 32 + j];
                unsigned wlo = __builtin_amdgcn_readfirstlane((unsigned)wv), whi = __builtin_amdgcn_readfirstlane((unsigned)(wv >> 32));
                unsigned long long w = ((unsigned long long)whi << 32) | wlo;
                while (w) { const int l2 = __builtin_ctzll(w); w &= w - 1ull;
                    const float pp = __builtin_bit_cast(float, __builtin_amdgcn_readlane(__builtin_bit_cast(int, sv[j]), l2));
                    o += pp * bf2f(vcol[(size_t)(64 * j + l2) * 512]); }
            }
        }
        o = o / lsum;
        const float z = bf2f(ZB[(size_t)tok * 512 + h * 64 + lane]);
        const float v = o * z / (1.0f + __expf(-z));
        const float ss = wave_sum(v * v);
        if (lane == 0) red[h] = ss;
        __syncthreads();
        float ssb = 0.f, ssa = 0.f;
#pragma unroll
        for (int i = 0; i < 8; ++i) { ssb += red[i]; ssa += SSA[(size_t)tok * 8 + i]; }
        const float rsb = 1.0f / sqrtf(ssb * (1.0f / 512.0f) + EPS), rsa = 1.0f / sqrtf(ssa * (1.0f / 512.0f) + EPS);
        Y[(size_t)tok * DM + 512 + h * 64 + lane] = (bf16)f2bf(v * rsb / rsa);
        __syncthreads();
    }
}


typedef short bf16x8 __attribute__((ext_vector_type(8)));
typedef short s16x4 __attribute__((ext_vector_type(4)));
typedef float f32x16 __attribute__((ext_vector_type(16)));
typedef unsigned u32x2 __attribute__((ext_vector_type(2)));
struct AttnState { f32x16 o[2]; float m, l; };
__device__ __forceinline__ float swap_max(float v) { auto rr = __builtin_amdgcn_permlane32_swap(__float_as_uint(v), __float_as_uint(v), false, false); return fmaxf(__uint_as_float(rr[0]), __uint_as_float(rr[1])); }
__device__ __forceinline__ float swap_sum(float v) { auto rr = __builtin_amdgcn_permlane32_swap(__float_as_uint(v), __float_as_uint(v), false, false); return __uint_as_float(rr[0]) + __uint_as_float(rr[1]); }
__device__ __forceinline__ unsigned cvtpk(float lo, float hi) { unsigned r; asm volatile("v_cvt_pk_bf16_f32 %0, %1, %2" : "=v"(r) : "v"(lo), "v"(hi)); return r; }
__device__ __forceinline__ s16x4 vtr(const LAS unsigned char* p) { typedef short v4i16_t __attribute__((ext_vector_type(4))); return __builtin_bit_cast(s16x4, __builtin_amdgcn_ds_read_tr16_b64_v4i16((LAS v4i16_t*)p)); }
template <int NKT, class MaskF>
__device__ __forceinline__ void attn_step(AttnState& S, const bf16x8 (&qf)[4], const bf16x8 (&kf)[NKT][4], const LAS unsigned char* vrd, const MaskF& maskf) {
    f32x16 st[NKT];
#pragma unroll
    for (int p = 0; p < NKT; ++p) {
        st[p] = (f32x16){0.f, 0.f, 0.f, 0.f, 0.f, 0.f, 0.f, 0.f, 0.f, 0.f, 0.f, 0.f, 0.f, 0.f, 0.f, 0.f};
#pragma unroll
        for (int s = 0; s < 4; ++s) st[p] = __builtin_amdgcn_mfma_f32_32x32x16_bf16(kf[p][s], qf[s], st[p], 0, 0, 0);
    }
    float mx = -INFINITY;
#pragma unroll
    for (int p = 0; p < NKT; ++p)
#pragma unroll
        for (int r = 0; r < 16; ++r) { if (!maskf(p, r)) st[p][r] = -INFINITY; mx = fmaxf(mx, st[p][r]); }
    mx = swap_max(mx);
    const float m_new = fmaxf(S.m, mx);
    const float m_use = (m_new == -INFINITY) ? 0.f : m_new;
    const float alpha = __builtin_amdgcn_exp2f(S.m - m_use);
    S.m = m_new;
    float rs = 0.f;
#pragma unroll
    for (int p = 0; p < NKT; ++p)
#pragma unroll
        for (int r = 0; r < 16; ++r) { st[p][r] = __builtin_amdgcn_exp2f(st[p][r] - m_use); rs += st[p][r]; }
    S.l = S.l * alpha + rs;
#pragma unroll
    for (int r = 0; r < 16; ++r) { S.o[0][r] *= alpha; S.o[1][r] *= alpha; }
#pragma unroll
    for (int p = 0; p < NKT; ++p)
#pragma unroll
        for (int s2 = 0; s2 < 2; ++s2) {
            v4u pw; pw.x = cvtpk(st[p][8 * s2 + 0], st[p][8 * s2 + 1]); pw.y = cvtpk(st[p][8 * s2 + 2], st[p][8 * s2 + 3]); pw.z = cvtpk(st[p][8 * s2 + 4], st[p][8 * s2 + 5]); pw.w = cvtpk(st[p][8 * s2 + 6], st[p][8 * s2 + 7]);
            const bf16x8 pb = __builtin_bit_cast(bf16x8, pw);
#pragma unroll
            for (int n = 0; n < 2; ++n) {
                const s16x4 lo = vtr(vrd + (4 * p + 2 * s2) * 1024 + n * 512), hi4 = vtr(vrd + (4 * p + 2 * s2 + 1) * 1024 + n * 512);
                const bf16x8 va = (bf16x8){lo[0], lo[1], lo[2], lo[3], hi4[0], hi4[1], hi4[2], hi4[3]};
                S.o[n] = __builtin_amdgcn_mfma_f32_32x32x16_bf16(va, pb, S.o[n], 0, 0, 0);
            }
        }
}

__device__ __forceinline__ void p5_mixer_b_mfma(const Ctx& C, LAS unsigned char* lds) {
    const bf16* QB = (const bf16*)(C.ws + WS_QB); const bf16* KB = (const bf16*)(C.ws + WS_KB); const bf16* VB = (const bf16*)(C.ws + WS_VB); const bf16* ZB = (const bf16*)(C.ws + WS_ZB);
    const unsigned long long* MASK = (const unsigned long long*)(C.ws + WS_MASK);
    bf16* Y = (bf16*)(C.ws + WS_Y); const float* SSA = (const float*)(C.ws + WS_SSA);
    const int lane = C.lane, r = lane & 31, hi = lane >> 5, head = C.wave;
    LAS unsigned char* vl = lds + C.wave * 8192;
    LAS float* red = (LAS float*)(lds + 65536);
    const LAS unsigned char* vrd = vl + (4 * hi + ((lane & 15) >> 2)) * 64 + ((lane >> 4) & 1) * 32 + (lane & 3) * 8;
    LAS unsigned char* vwr = vl + (lane >> 3) * 64 + ((lane & 7) >> 2) * 512 + (lane & 3) * 16;
    for (int up = blockIdx.x; up < BATCH * 32; up += C.G) {
#pragma unroll 1
        for (int half = 0; half < 2; ++half) {
            const int b = up >> 5, qi = half ? 63 - (up & 31) : (up & 31);
            const size_t tokb = (size_t)b * SEQ; const int q0 = 32 * qi, nkt = (qi >> 1) + 1;
            const size_t qtok = tokb + q0 + r;
            bf16x8 qf[4];
#pragma unroll
            for (int s = 0; s < 4; ++s) qf[s] = *(const bf16x8*)(QB + qtok * 512 + head * 64 + 16 * s + 8 * hi);
            const unsigned long long* mrow = MASK + qtok * 32;
            AttnState S; S.m = -INFINITY; S.l = 0.f;
#pragma unroll
            for (int i = 0; i < 16; ++i) { S.o[0][i] = 0.f; S.o[1][i] = 0.f; }
            bf16x8 kn[2][4]; v4u vn[8]; unsigned long long wn;
            {
                const bf16* kp = KB + (tokb + r) * 64 + 8 * hi;
#pragma unroll
                for (int p = 0; p < 2; ++p)
#pragma unroll
                    for (int s = 0; s < 4; ++s) kn[p][s] = *(const bf16x8*)(kp + (size_t)p * 32 * 64 + 16 * s);
                const bf16* vp = VB + (tokb + (lane >> 3)) * 512 + head * 64 + (lane & 7) * 8;
#pragma unroll
                for (int i = 0; i < 8; ++i) vn[i] = *(const v4u*)(vp + (size_t)i * 8 * 512);
                wn = mrow[0];
            }
#pragma unroll 1
            for (int kt = 0; kt < nkt; ++kt) {
                bf16x8 kc[2][4];
#pragma unroll
                for (int p = 0; p < 2; ++p)
#pragma unroll
                    for (int s = 0; s < 4; ++s) kc[p][s] = kn[p][s];
                const unsigned long long wc = wn;
#pragma unroll
                for (int i = 0; i < 8; ++i) *(LAS v4u*)(vwr + i * 1024) = vn[i];
                if (kt + 1 < nkt) {
                    const bf16* kp = KB + (tokb + 64 * (kt + 1) + r) * 64 + 8 * hi;
#pragma unroll
                    for (int p = 0; p < 2; ++p)
#pragma unroll
                        for (int s = 0; s < 4; ++s) kn[p][s] = *(const bf16x8*)(kp + (size_t)p * 32 * 64 + 16 * s);
                    const bf16* vp = VB + (tokb + 64 * (kt + 1) + (lane >> 3)) * 512 + head * 64 + (lane & 7) * 8;
#pragma unroll
                    for (int i = 0; i < 8; ++i) vn[i] = *(const v4u*)(vp + (size_t)i * 8 * 512);
                    wn = mrow[kt + 1];
                }
                const unsigned wlo = (unsigned)(wc >> (4 * hi)), whi = (unsigned)(wc >> (32 + 4 * hi));
                auto maskf = [&](int p, int reg) -> bool { return (((p ? whi : wlo) >> ((reg & 3) + 8 * (reg >> 2))) & 1u) != 0u; };
                attn_step<2>(S, qf, kc, vrd, maskf);
            }
            const float linv = 1.0f / swap_sum(S.l);
            float ss = 0.f; float vv[2][16];
#pragma unroll
            for (int n = 0; n < 2; ++n)
#pragma unroll
                for (int g = 0; g < 4; ++g) {
                    const u32x2 zw = *(const u32x2*)(ZB + qtok * 512 + head * 64 + 32 * n + 8 * g + 4 * hi);
                    const float z[4] = {bflo(zw.x), bfhi(zw.x), bflo(zw.y), bfhi(zw.y)};
#pragma unroll
                    for (int e = 0; e < 4; ++e) { const float o = S.o[n][4 * g + e] * linv; const float v = o * z[e] / (1.0f + __expf(-z[e])); vv[n][4 * g + e] = v; ss += v * v; }
                }
            ss = swap_sum(ss);
            if (hi == 0) red[head * 32 + r] = ss;
            __syncthreads();
            float ssb = 0.f;
#pragma unroll
            for (int w = 0; w < 8; ++w) ssb += red[w * 32 + r];
            const f32x4 a0 = *(const f32x4*)(SSA + qtok * 8), a1 = *(const f32x4*)(SSA + qtok * 8 + 4);
            const float ssa = ((a0[0] + a0[1]) + (a0[2] + a0[3])) + ((a1[0] + a1[1]) + (a1[2] + a1[3]));
            const float scale = sqrtf(ssa * (1.0f / 512.0f) + EPS) / sqrtf(ssb * (1.0f / 512.0f) + EPS);
#pragma unroll
            for (int n = 0; n < 2; ++n)
#pragma unroll
                for (int g = 0; g < 4; ++g) {
                    u32x2 w; w.x = cvtpk(vv[n][4 * g] * scale, vv[n][4 * g + 1] * scale); w.y = cvtpk(vv[n][4 * g + 2] * scale, vv[n][4 * g + 3] * scale);
                    *(u32x2*)(Y + qtok * DM + 512 + head * 64 + 32 * n + 8 * g + 4 * hi) = w;
                }
            __syncthreads();
        }
    }
}


__device__ __forceinline__ void p4_mixer_a_mfma(const Ctx& C, LAS unsigned char* lds) {
    const bf16* QA = (const bf16*)(C.ws + WS_QA); const bf16* KA = (const bf16*)(C.ws + WS_KA); const bf16* VA = (const bf16*)(C.ws + WS_VA); const bf16* ZA = (const bf16*)(C.ws + WS_ZA);
    bf16* Y = (bf16*)(C.ws + WS_Y); float* SSA = (float*)(C.ws + WS_SSA);
    const int lane = C.lane, r = lane & 31, hi = lane >> 5, w = C.wave;
    LAS unsigned char* vl = lds + w * 8192;
    LAS float* OST = (LAS float*)(lds + 65536);
    LAS float* MST = (LAS float*)(lds + 65536 + 69632);
    LAS float* LST = MST + 256;
    const LAS unsigned char* vrd = vl + (4 * hi + ((lane & 15) >> 2)) * 64 + ((lane >> 4) & 1) * 32 + (lane & 3) * 8;
    LAS unsigned char* vwr = vl + (lane >> 3) * 64 + ((lane & 7) >> 2) * 512 + (lane & 3) * 16;
    for (int unit = blockIdx.x; unit < BATCH * 64; unit += C.G) {
        const int b = unit >> 6, c = (unit >> 3) & 7, head = unit & 7, t0 = 256 * c; const size_t tokb = (size_t)b * SEQ;
        const bf16* Kh = KA + tokb * 512 + head * 64; const bf16* Vh = VA + tokb * 512 + head * 64;
#pragma unroll 1
        for (int jj = 0; jj < 4; ++jj) {
            if (jj == 1 || jj == 2) __syncthreads();
            int ld, rr, j0, nq;
            if (jj == 0) { ld = 0; rr = 0; j0 = t0 + 32 * w; nq = 32; }
            else if (jj == 1) { ld = 2; rr = w & 3; j0 = (t0 >> 2) + 32 * (w >> 2); nq = 32; }
            else { ld = 4; rr = 2 * w + (jj - 2); j0 = t0 >> 4; nq = 16; }
            const bool rowok = r < nq;
            const int jq = j0 + (rowok ? r : nq - 1);
            const int qpos = (jq << ld) + rr, lrow = qpos - t0;
            const size_t qtok = tokb + qpos;
            bf16x8 qf[4];
#pragma unroll
            for (int s = 0; s < 4; ++s) qf[s] = *(const bf16x8*)(QA + qtok * 512 + head * 64 + 16 * s + 8 * hi);
            AttnState S;
            if (jj == 0) {
                S.m = -INFINITY; S.l = 0.f;
#pragma unroll
                for (int i = 0; i < 16; ++i) { S.o[0][i] = 0.f; S.o[1][i] = 0.f; }
            } else {
                S.m = MST[lrow]; S.l = LST[hi * 256 + lrow];
#pragma unroll
                for (int n = 0; n < 2; ++n)
#pragma unroll
                    for (int g = 0; g < 4; ++g) { const f32x4 v = *(const LAS f32x4*)(OST + lrow * 68 + 32 * n + 8 * g + 4 * hi); S.o[n][4 * g] = v[0]; S.o[n][4 * g + 1] = v[1]; S.o[n][4 * g + 2] = v[2]; S.o[n][4 * g + 3] = v[3]; }
            }
            const int ks = j0 - 128;
            const unsigned lim = (unsigned)(jq < 128 ? jq : 128);
            const int dq0 = rowok ? (jq - ks - 4 * hi) : -100000;
            const bool act0 = (ks + 63 >= 0), act1 = (ks + 127 >= 0);
            bf16x8 kn[2][4]; v4u vn[8];
            auto load_tile = [&](int i) {
#pragma unroll
                for (int p = 0; p < 2; ++p) { int jk = ks + 64 * i + 32 * p + r; jk = jk < 0 ? 0 : jk; int ps = (jk << ld) + rr; ps = ps > SEQ - 1 ? SEQ - 1 : ps; const bf16* kp = Kh + (size_t)ps * 512 + 8 * hi;
#pragma unroll
                    for (int s = 0; s < 4; ++s) kn[p][s] = *(const bf16x8*)(kp + 16 * s); }
#pragma unroll
                for (int ii = 0; ii < 8; ++ii) { int jk = ks + 64 * i + 8 * ii + (lane >> 3); jk = jk < 0 ? 0 : jk; int ps = (jk << ld) + rr; ps = ps > SEQ - 1 ? SEQ - 1 : ps; vn[ii] = *(const v4u*)(Vh + (size_t)ps * 512 + (lane & 7) * 8); }
            };
            const int i0 = act0 ? 0 : (act1 ? 1 : 2);
            load_tile(i0);
#pragma unroll 1
            for (int i = i0; i < 3; ++i) {
                bf16x8 kc[2][4];
#pragma unroll
                for (int p = 0; p < 2; ++p)
#pragma unroll
                    for (int s = 0; s < 4; ++s) kc[p][s] = kn[p][s];
#pragma unroll
                for (int ii = 0; ii < 8; ++ii) *(LAS v4u*)(vwr + ii * 1024) = vn[ii];
                if (i + 1 < 3) load_tile(i + 1);
                const int dq = dq0 - 64 * i;
                auto maskf = [&](int p, int reg) -> bool { return (unsigned)(dq - 32 * p - ((reg & 3) + 8 * (reg >> 2))) <= lim; };
                if (i < 2) attn_step<2>(S, qf, kc, vrd, maskf);
                else { const bf16x8 (&k1)[1][4] = *reinterpret_cast<const bf16x8 (*)[1][4]>(&kc[0]); attn_step<1>(S, qf, k1, vrd, maskf); }
            }
            if (jj < 2) {
                if (hi == 0) MST[lrow] = S.m;
                LST[hi * 256 + lrow] = S.l;
#pragma unroll
                for (int n = 0; n < 2; ++n)
#pragma unroll
                    for (int g = 0; g < 4; ++g) *(LAS f32x4*)(OST + lrow * 68 + 32 * n + 8 * g + 4 * hi) = (f32x4){S.o[n][4 * g], S.o[n][4 * g + 1], S.o[n][4 * g + 2], S.o[n][4 * g + 3]};
            } else {
                const float linv = 1.0f / swap_sum(S.l);
                float ss = 0.f; float vv[2][16];
#pragma unroll
                for (int n = 0; n < 2; ++n)
#pragma unroll
                    for (int g = 0; g < 4; ++g) {
                        const u32x2 zw = *(const u32x2*)(ZA + qtok * 512 + head * 64 + 32 * n + 8 * g + 4 * hi);
                        const float z[4] = {bflo(zw.x), bfhi(zw.x), bflo(zw.y), bfhi(zw.y)};
#pragma unroll
                        for (int e = 0; e < 4; ++e) { const float o = S.o[n][4 * g + e] * linv; const float v = o * z[e] / (1.0f + __expf(-z[e])); vv[n][4 * g + e] = v; ss += v * v; }
                    }
                ss = swap_sum(ss);
                if (rowok) {
                    if (hi == 0) SSA[qtok * 8 + head] = ss;
#pragma unroll
                    for (int n = 0; n < 2; ++n)
#pragma unroll
                        for (int g = 0; g < 4; ++g) { u32x2 wv; wv.x = cvtpk(vv[n][4 * g], vv[n][4 * g + 1]); wv.y = cvtpk(vv[n][4 * g + 2], vv[n][4 * g + 3]); *(u32x2*)(Y + qtok * DM + head * 64 + 32 * n + 8 * g + 4 * hi) = wv; }
                }
            }
        }
        __syncthreads();
    }
}


__device__ __forceinline__ void p3_indexer_mfma(const Ctx& C, LAS unsigned char* lds) {
    constexpr int SROW = 2052;
    LAS float* scores = (LAS float*)lds;
    const bf16* IQ = (const bf16*)(C.ws + WS_IQ); const bf16* IKN = (const bf16*)(C.ws + WS_IKN); const float* IW = (const float*)(C.ws + WS_IW);
    unsigned long long* MASK = (unsigned long long*)(C.ws + WS_MASK);
    const int lane = C.lane, q = lane & 15, g = lane >> 4, w = C.wave;
    int k = 0;
    for (int u = blockIdx.x; u < BATCH * 128; u += C.G, ++k) {
        const int b = u >> 7, q1 = u & 127, qt = (k & 1) ? 127 - q1 : q1, t0 = qt * 16; const size_t tokb = (size_t)b * SEQ;
        bf16x8 bq[4][2];
#pragma unroll
        for (int h = 0; h < 4; ++h)
#pragma unroll
            for (int ks = 0; ks < 2; ++ks) bq[h][ks] = *(const bf16x8*)(IQ + (tokb + t0 + q) * 256 + h * 64 + 32 * ks + 8 * g);
        const f32x4 wq = *(const f32x4*)(IW + (tokb + t0 + q) * 4);
        const int ntiles = qt + 1;
#pragma unroll 1
        for (int tl = w; tl < ntiles; tl += NWAVES) {
            const bf16* kp = IKN + (tokb + 16 * tl + q) * 64 + 8 * g;
            const bf16x8 a0 = *(const bf16x8*)kp, a1 = *(const bf16x8*)(kp + 32);
            f32x4 sc = {0.f, 0.f, 0.f, 0.f};
#pragma unroll
            for (int h = 0; h < 4; ++h) {
                f32x4 acc = {0.f, 0.f, 0.f, 0.f};
                acc = __builtin_amdgcn_mfma_f32_16x16x32_bf16(a0, bq[h][0], acc, 0, 0, 0);
                acc = __builtin_amdgcn_mfma_f32_16x16x32_bf16(a1, bq[h][1], acc, 0, 0, 0);
#pragma unroll
                for (int e = 0; e < 4; ++e) sc[e] += wq[h] * fmaxf(acc[e], 0.f);
            }
            *(LAS f32x4*)(scores + q * SROW + 16 * tl + 4 * g) = sc;
        }
        __syncthreads();
#pragma unroll 1
        for (int qq = 0; qq < 2; ++qq) { const int qi = w * 2 + qq, t = t0 + qi; select_topk(scores + qi * SROW, t, MASK + (tokb + t) * 32, lane); }
        __syncthreads();
    }
}

__device__ __forceinline__ void p7_final_norm(const Ctx& C) {
    for (int m = C.gw; m < M; m += C.NGW) {
        GAS f32x4* xr = (GAS f32x4*)(C.out + (size_t)m * DM) + C.lane;
        const GAS f32x4* gr = (const GAS f32x4*)C.g_fin + C.lane;
        f32x4 v[4]; float s = 0.f;
#pragma unroll
        for (int j = 0; j < 4; ++j) { v[j] = xr[64 * j]; s += (v[j].x * v[j].x + v[j].y * v[j].y) + (v[j].z * v[j].z + v[j].w * v[j].w); }
        const float rs = 1.0f / sqrtf(wave_sum(s) * (1.0f / DM) + EPS);
#pragma unroll
        for (int j = 0; j < 4; ++j) xr[64 * j] = v[j] * rs * gr[64 * j];
    }
}

#ifndef P5_MFMA
#define P5_MFMA 1
#endif
#ifndef P3_MFMA
#define P3_MFMA 1
#endif
#ifndef P4_MFMA
#define P4_MFMA 1
#endif
struct Args { const void* in[12]; float* out; unsigned char* ws; int ph_lo, ph_hi, li, pad; };
__global__ void __launch_bounds__(NWAVES * 64, 2) mk_fwd(Args args) {
    extern __shared__ __attribute__((aligned(16))) unsigned char lds_raw[];
    LAS unsigned char* lds = (LAS unsigned char*)lds_raw;
    Ctx C;
    C.x = (const float*)args.in[0]; C.pos = (const int*)args.in[1]; C.g_in = (const float*)args.in[2]; C.w_in = (const float*)args.in[3]; C.g_kv = (const float*)args.in[4];
    C.w_uk = (const float*)args.in[5]; C.w_uv = (const float*)args.in[6]; C.g_ik = (const float*)args.in[7]; C.g_a = (const float*)args.in[8]; C.g_b = (const float*)args.in[9];
    C.w_out = (const float*)args.in[10]; C.g_fin = (const float*)args.in[11]; C.out = args.out; C.ws = args.ws;
    C.tid = threadIdx.x; C.lane = C.tid & 63; C.wave = __builtin_amdgcn_readfirstlane(C.tid >> 6); C.G = gridDim.x;
    C.gw = blockIdx.x * NWAVES + C.wave; C.NGW = C.G * NWAVES;
    volatile LAS unsigned* LCTL = (volatile LAS unsigned*)(lds + LDSCTL_OFF);
    if (C.tid < 64) LCTL[C.tid] = 0u;
    __syncthreads();
    gu32* ctl = (gu32*)(args.ws + WS_CTL);
    XcdBarrier bar; bar.bar = (unsigned*)(ctl + CW_BAR); bar.x = 0; bar.st = nullptr;
    if (N_LAUNCHES == 1) bar = xcd_barrier_post((unsigned*)(ctl + CW_BAR), LCTL);
    const int lo = args.ph_lo, hi = args.ph_hi;
#define IN(k) (lo <= (k) && (k) < hi)
#define SEAM(k) do { if (IN(k) && IN((k) + 1)) xcd_barrier(bar); } while (0)

    if (IN(0)) { p0_prologue(C, lds); SEAM(0); }
    if (IN(1)) {
        pg8::Gemm g{(const pg8::bf16_t*)(C.ws + WS_XN), (const pg8::bf16_t*)(C.ws + WS_WIN), M, NPROJ, DM}; pg8::StaticOrder S; S.init(M, NPROJ, C.G, (int)blockIdx.x);
        pg8::EpiProj E{C.ws, (const float*)(C.ws + WS_CS)};
        pg8::gemm_phase<pg8::EpiProj, pg8::StaticOrder, true, true>(lds, g, S, E);
        SEAM(1);
    }
    if (IN(2)) { p2_token_local(C, lds); SEAM(2); }
    if (IN(3)) { if (P3_MFMA) p3_indexer_mfma(C, lds); else p3_indexer(C, lds); }
    if (IN(4)) { if (P4_MFMA) p4_mixer_a_mfma(C, lds); else p4_mixer_a(C); SEAM(4); }
    if (IN(5)) { if (P5_MFMA) p5_mixer_b_mfma(C, lds); else p5_mixer_b(C, lds); SEAM(5); }
    if (IN(6)) {
        pg8::Gemm g{(const pg8::bf16_t*)(C.ws + WS_Y), (const pg8::bf16_t*)(C.ws + WS_WOUT), M, DM, DM}; pg8::StaticOrder S; S.init(M, DM, C.G, (int)blockIdx.x);
        pg8::EpiOut E{C.x, C.out, (const float*)(C.ws + WS_SSA)};
        pg8::gemm_phase<pg8::EpiOut, pg8::StaticOrder, true, true>(lds, g, S, E);
        SEAM(6);
    }
    if (IN(7)) { p7_final_norm(C); }
#undef IN
#undef SEAM
}

extern "C" void kernel_launch(void* const* d_in, const int* in_sizes, int n_in, void* d_out, int out_size, void* d_ws, size_t ws_size, hipStream_t stream) {
    static int grid = 0;
    if (grid == 0) {
        if (n_in != 12 || in_sizes[0] != M * DM || out_size != M * DM || ws_size < WS_END) { fprintf(stderr, "kernel_launch: unexpected shapes (n_in %d, in0 %d, out %d, ws %zu)\n", n_in, n_in > 0 ? in_sizes[0] : -1, out_size, ws_size); grid = -1; return; }
        int dev = 0, cus = 0, per_cu = 0;
        if (hipGetDevice(&dev) != hipSuccess || hipDeviceGetAttribute(&cus, hipDeviceAttributeMultiprocessorCount, dev) != hipSuccess) { grid = -1; return; }
        if (hipFuncSetAttribute((const void*)mk_fwd, hipFuncAttributeMaxDynamicSharedMemorySize, LDS_BYTES) != hipSuccess) { fprintf(stderr, "kernel_launch: hipFuncSetAttribute failed\n"); grid = -1; return; }
        if (hipOccupancyMaxActiveBlocksPerMultiprocessor(&per_cu, (const void*)mk_fwd, NWAVES * 64, LDS_BYTES) != hipSuccess || per_cu < 1) fprintf(stderr, "kernel_launch: occupancy query reports %d\n", per_cu);
        (void)hipGetLastError();
        grid = cus;
    }
    if (grid < 0) return;
    if (hipMemsetAsync((char*)d_ws + WS_CTL, 0, CTL_ZERO_BYTES, stream) != hipSuccess) return;
    Args a{};
    for (int i = 0; i < 12; ++i) a.in[i] = d_in[i];
    a.out = (float*)d_out; a.ws = (unsigned char*)d_ws;
    for (int li = 0; li < N_LAUNCHES; ++li) {
        a.ph_lo = (N_LAUNCHES == 1) ? 0 : li; a.ph_hi = (N_LAUNCHES == 1) ? N_PHASES : li + 1; a.li = li;
        hipLaunchKernelGGL(mk_fwd, dim3(grid), dim3(NWAVES * 64), LDS_BYTES, stream, a);
        const hipError_t le = hipPeekAtLastError();
        if (le != hipSuccess) { fprintf(stderr, "kernel_launch: launch %d failed: %s\n", li, hipGetErrorName(le)); break; }
    }
}
```

```cpp
#include <hip/hip_runtime.h>
#include <cstdio>
#include <cstdint>
namespace pg8 {
#define PG8_LAS __attribute__((address_space(3)))
typedef unsigned short bf16_t;
typedef short bf16x8 __attribute__((ext_vector_type(8)));
typedef float f32x4 __attribute__((ext_vector_type(4)));
typedef unsigned u32x4 __attribute__((ext_vector_type(4)));
constexpr int BM = 256, BK = 64, HALF = 128, HTB = HALF * BK * 2  , STAGE_BYTES = 8 * HTB, NXCD = 8, WGM = 8;

__host__ __device__ __forceinline__ int lds_byte(int r, int c) { const int st = (r >> 4) * 2 + (c >> 5), rr = r & 15, cc = c & 31, ob = rr * 64 + cc * 2; return st * 1024 + (ob ^ (((ob >> 9) & 1) << 5)); }
__host__ __device__ __forceinline__ void stage_rc(int b, int& R, int& C) { const int st = b / 1024, sb = b % 1024, swz = sb ^ (((sb >> 9) & 1) << 5); R = (st >> 1) * 16 + swz / 64; C = (st & 1) * 32 + (swz % 64) / 2; }
__host__ __device__ __forceinline__ int perm32(int rho) { const int n = rho >> 4, i = rho & 15; return 8 * (i >> 2) + 4 * n + (i & 3); }

struct Unit { int pm, pn; };
struct Gemm { const bf16_t* A; const bf16_t* Bt; int M, N, K; };

struct StaticOrder {
    int nM, nN, nwg, G, c;
    __host__ __device__ void init(int M, int N, int G_, int c_) { nM = M / BM; nN = N / BM; nwg = nM * nN; G = G_; c = c_; }
    __host__ __device__ bool next(int i, Unit& u) const {
        const long L = (long)i * G + c; if (L >= nwg) return false;
        int wgid = (int)L; { const int q = nwg / NXCD, r = nwg % NXCD, xcd = wgid % NXCD, off = wgid / NXCD; wgid = (xcd < r ? xcd * (q + 1) : r * (q + 1) + (xcd - r) * q) + off; }
        const int nig = WGM * nN, gid = wgid / nig, fm = gid * WGM, gsz = (nM - fm) < WGM ? (nM - fm) : WGM;
        u.pm = fm + ((wgid % nig) % gsz); u.pn = (wgid % nig) / gsz; return true;
    }
    __device__ __forceinline__ void a_ready(const Unit&) const {}
    __device__ __forceinline__ void done(const Unit&) const {}
};

template <class Epi, class Sched, bool ALIGN_EPI = false, bool SP2 = false>
__device__ __forceinline__ void gemm_phase(PG8_LAS unsigned char* lds, const Gemm g, const Sched& S, const Epi& E) {
    const int tid = threadIdx.x, wid = __builtin_amdgcn_readfirstlane(tid >> 6), lane = tid & 63, wr = wid >> 2, wc = wid & 3, fr = lane & 15, fq = lane >> 4;
    const int K = g.K, nt = K / BK;
    unsigned voffA[2], voffB[2];
#pragma unroll
    for (int i = 0; i < 2; ++i) { int R, C; stage_rc(tid * 16 + i * 8192, R, C); const int Rb = Epi::PERM ? ((R & ~31) + perm32(R & 31)) : R;
        voffA[i] = (unsigned)(R * K + C) * 2u; voffB[i] = (unsigned)(Rb * K + C) * 2u; }
    const size_t kstep = (size_t)(BK * 2);
    const size_t hstep = (size_t)HALF * K * 2;
    const size_t tstep = 2 * hstep;
    const unsigned ldsw = (unsigned)wid * 1024u;
    const int aoff = lds_byte(wr * 64 + fr, fq * 8), boff = lds_byte(wc * 32 + fr, fq * 8);
#define PG8_SA(b, h) (((b) * 2 + (h)) * HTB)
#define PG8_SB(b, h) ((4 + (b) * 2 + (h)) * HTB)
#define PG8_STAGE(bufoff, gbase, voff) do { _Pragma("unroll") for (int _i = 0; _i < 2; ++_i) \
        __builtin_amdgcn_global_load_lds((const unsigned*)((const char*)(gbase) + (voff)[_i]), (PG8_LAS unsigned*)(lds + (bufoff) + ldsw + _i * 8192), 16, 0, 0); } while (0)
#define PG8_LDA(dst, b, h) do { _Pragma("unroll") for (int m = 0; m < 4; ++m) _Pragma("unroll") for (int k = 0; k < 2; ++k) dst[m][k] = *(const PG8_LAS bf16x8*)(lds + PG8_SA(b, h) + aoff + m * 2048 + k * 1024); } while (0)
#define PG8_LDB(dst, b, h) do { _Pragma("unroll") for (int n = 0; n < 2; ++n) _Pragma("unroll") for (int k = 0; k < 2; ++k) dst[n][k] = *(const PG8_LAS bf16x8*)(lds + PG8_SB(b, h) + boff + n * 2048 + k * 1024); } while (0)
#define PG8_MMA(ai, bj, At, Bt) do { __builtin_amdgcn_s_setprio(1); _Pragma("unroll") for (int m = 0; m < 4; ++m) _Pragma("unroll") for (int n = 0; n < 2; ++n) _Pragma("unroll") for (int k = 0; k < 2; ++k) \
        acc[ai][bj][m][n] = __builtin_amdgcn_mfma_f32_16x16x32_bf16(Bt[n][k], At[m][k], acc[ai][bj][m][n], 0, 0, 0); __builtin_amdgcn_s_setprio(0); } while (0)
#define PG8_WAIT_V(n) asm volatile("s_waitcnt vmcnt(" #n ")" ::: "memory")
#define PG8_WAIT_L(n) asm volatile("s_waitcnt lgkmcnt(" #n ")" ::: "memory")
#define PG8_BAR __builtin_amdgcn_s_barrier()
#define PG8_SCHED __builtin_amdgcn_sched_barrier(0)
    Unit cur, nxt; int ui = 0;
    if (!S.next(0, cur)) return;
    f32x4 acc[2][2][4][2];
#pragma unroll
    for (int a = 0; a < 2; ++a)
#pragma unroll
        for (int b = 0; b < 2; ++b)
#pragma unroll
            for (int m = 0; m < 4; ++m)
#pragma unroll
                for (int n = 0; n < 2; ++n) acc[a][b][m][n] = (f32x4){0.f, 0.f, 0.f, 0.f};
    bf16x8 At[4][2], B0[2][2], B1[2][2];
    const char* cA = (const char*)g.A + (size_t)cur.pm * tstep; const char* cB = (const char*)g.Bt + (size_t)cur.pn * tstep;
    S.a_ready(cur);
    if constexpr (SP2) {
        PG8_STAGE(PG8_SB(0, 0), cB, voffB); PG8_STAGE(PG8_SB(0, 1), cB + hstep, voffB); PG8_STAGE(PG8_SA(0, 0), cA, voffA); PG8_STAGE(PG8_SA(0, 1), cA + hstep, voffA);
        if (wr == 1) PG8_BAR;
        PG8_WAIT_V(2); PG8_BAR;
        PG8_STAGE(PG8_SB(1, 0), cB + kstep, voffB); PG8_STAGE(PG8_SA(1, 0), cA + kstep, voffA); PG8_STAGE(PG8_SB(1, 1), cB + hstep + kstep, voffB);
        PG8_WAIT_V(6); PG8_BAR;
    } else {
        PG8_STAGE(PG8_SB(0, 0), cB, voffB); PG8_STAGE(PG8_SA(0, 0), cA, voffA); PG8_STAGE(PG8_SB(0, 1), cB + hstep, voffB); PG8_STAGE(PG8_SA(0, 1), cA + hstep, voffA);
        if (wr == 1) PG8_BAR;
        PG8_WAIT_V(4); PG8_BAR;
        PG8_STAGE(PG8_SB(1, 0), cB + kstep, voffB); PG8_STAGE(PG8_SA(1, 0), cA + kstep, voffA); PG8_STAGE(PG8_SB(1, 1), cB + hstep + kstep, voffB);
        PG8_WAIT_V(6); PG8_BAR;
    }
    for (;;) {
        const bool has_next = S.next(ui + 1, nxt);
        const char* nA = has_next ? (const char*)g.A + (size_t)nxt.pm * tstep : cA; const char* nB = has_next ? (const char*)g.Bt + (size_t)nxt.pn * tstep : cB;
        for (int t = 0; t < nt; t += 2) {
            const bool last = (t == nt - 2);
            const char* a1 = cA + (size_t)(t + 1) * kstep;
            const char* a2 = last ? nA : cA + (size_t)(t + 2) * kstep; const char* b2 = last ? nB : cB + (size_t)(t + 2) * kstep;
            const char* a3 = a2 + kstep; const char* b3 = b2 + kstep;
            if (last && has_next) S.a_ready(nxt);
            if constexpr (SP2) {
            PG8_LDB(B0, 0, 0); PG8_LDB(B1, 0, 1); PG8_SCHED; PG8_LDA(At, 0, 0); PG8_STAGE(PG8_SA(1, 1), a1 + hstep, voffA);
            PG8_WAIT_V(8); PG8_WAIT_L(0); PG8_BAR; PG8_MMA(0, 0, At, B0); PG8_MMA(0, 1, At, B1); PG8_BAR; PG8_SCHED;
            PG8_LDA(At, 0, 1); PG8_STAGE(PG8_SB(0, 0), b2, voffB); PG8_STAGE(PG8_SB(0, 1), b2 + hstep, voffB); PG8_STAGE(PG8_SA(0, 0), a2, voffA);
            PG8_WAIT_V(8); PG8_WAIT_L(0); PG8_BAR; PG8_MMA(1, 0, At, B0); PG8_MMA(1, 1, At, B1); PG8_BAR; PG8_SCHED;
            PG8_LDB(B0, 1, 0); PG8_LDB(B1, 1, 1); PG8_SCHED; PG8_LDA(At, 1, 0); PG8_STAGE(PG8_SA(0, 1), a2 + hstep, voffA);
            PG8_WAIT_V(8); PG8_WAIT_L(0); PG8_BAR; PG8_MMA(0, 0, At, B0); PG8_MMA(0, 1, At, B1); PG8_BAR; PG8_SCHED;
            PG8_LDA(At, 1, 1); PG8_STAGE(PG8_SB(1, 0), b3, voffB); PG8_STAGE(PG8_SB(1, 1), b3 + hstep, voffB); PG8_STAGE(PG8_SA(1, 0), a3, voffA);
            PG8_WAIT_V(8); PG8_WAIT_L(0); PG8_BAR; PG8_MMA(1, 0, At, B0); PG8_MMA(1, 1, At, B1); PG8_BAR; PG8_SCHED;
            } else {
            PG8_LDB(B0, 0, 0); PG8_SCHED; PG8_LDA(At, 0, 0); PG8_STAGE(PG8_SA(1, 1), a1 + hstep, voffA);
            PG8_WAIT_L(8); PG8_BAR; PG8_WAIT_L(0); PG8_MMA(0, 0, At, B0); PG8_BAR; PG8_SCHED;
            PG8_LDB(B1, 0, 1); PG8_STAGE(PG8_SB(0, 0), b2, voffB);
            PG8_BAR; PG8_WAIT_L(0); PG8_MMA(0, 1, At, B1); PG8_BAR;
            PG8_LDA(At, 0, 1); PG8_STAGE(PG8_SA(0, 0), a2, voffA);
            PG8_BAR; PG8_WAIT_L(0); PG8_MMA(1, 0, At, B0); PG8_BAR; PG8_SCHED;
            PG8_STAGE(PG8_SB(0, 1), b2 + hstep, voffB);
            PG8_WAIT_V(6); PG8_BAR; PG8_MMA(1, 1, At, B1); PG8_BAR;
            PG8_LDB(B0, 1, 0); PG8_SCHED; PG8_LDA(At, 1, 0); PG8_STAGE(PG8_SA(0, 1), a2 + hstep, voffA);
            PG8_WAIT_L(8); PG8_BAR; PG8_WAIT_L(0); PG8_MMA(0, 0, At, B0); PG8_BAR; PG8_SCHED;
            PG8_LDB(B1, 1, 1); PG8_STAGE(PG8_SB(1, 0), b3, voffB);
            PG8_BAR; PG8_WAIT_L(0); PG8_MMA(0, 1, At, B1); PG8_BAR;
            PG8_LDA(At, 1, 1); PG8_STAGE(PG8_SA(1, 0), a3, voffA);
            PG8_BAR; PG8_WAIT_L(0); PG8_MMA(1, 0, At, B0); PG8_BAR; PG8_SCHED;
            PG8_STAGE(PG8_SB(1, 1), b3 + hstep, voffB);
            PG8_WAIT_V(6); PG8_BAR; PG8_MMA(1, 1, At, B1); PG8_BAR;
            }
        }
        if constexpr (ALIGN_EPI) { if (wr == 0) PG8_BAR; }
        if constexpr (!Epi::AFTER_DRAIN) { E(acc, cur, wr, wc, fr, fq); S.done(cur); }
        if (!has_next) break;
#pragma unroll
        for (int a = 0; a < 2; ++a)
#pragma unroll
            for (int b = 0; b < 2; ++b)
#pragma unroll
                for (int m = 0; m < 4; ++m)
#pragma unroll
                    for (int n = 0; n < 2; ++n) acc[a][b][m][n] = (f32x4){0.f, 0.f, 0.f, 0.f};
        cur = nxt; cA = nA; cB = nB; ++ui;
        if constexpr (ALIGN_EPI) { if (wr == 1) PG8_BAR; }
    }
    PG8_WAIT_V(0);
    if constexpr (!ALIGN_EPI) { if (wr == 0) PG8_BAR; }
    PG8_BAR;
    if constexpr (Epi::AFTER_DRAIN) { E.fused(acc, cur, wr, wc, fr, fq, lds, wid, lane); S.done(cur); }
#undef PG8_SA
#undef PG8_SB
#undef PG8_STAGE
#undef PG8_LDA
#undef PG8_LDB
#undef PG8_MMA
#undef PG8_WAIT_V
#undef PG8_WAIT_L
#undef PG8_BAR
#undef PG8_SCHED
}
}

#ifndef MK_N_LAUNCHES
#define MK_N_LAUNCHES 1
#endif
constexpr int N_LAUNCHES = MK_N_LAUNCHES;
constexpr int N_PHASES = 8;
#ifndef REPEAT_PHASE
#define REPEAT_PHASE -1
#endif

constexpr int NWAVES = 8;
constexpr int BATCH = 16, SEQ = 2048, DM = 1024, M = BATCH * SEQ;
constexpr int DIN = 3524, NPROJ = 3584;
constexpr float EPS = 1e-6f;
constexpr float C2 = 0.125f * 1.4426950408889634f;

constexpr size_t MiB = 1u << 20;
constexpr size_t WS_CTL = 0, CTL_ZERO_BYTES = 1 * MiB;
constexpr size_t WS_WIN = 2 * MiB;
constexpr size_t WS_WOUT = 10 * MiB;
constexpr size_t WS_CS = 12 * MiB;
constexpr size_t WS_SSA = 14 * MiB;
constexpr size_t WS_WCAT = 15 * MiB;
constexpr size_t WS_XN = 16 * MiB;
constexpr size_t WS_Y = WS_XN;
constexpr size_t WS_QA = 80 * MiB;
constexpr size_t WS_KA = WS_QA + 32 * MiB, WS_VA = WS_QA + 64 * MiB, WS_ZA = WS_QA + 96 * MiB, WS_QB = WS_QA + 128 * MiB, WS_ZB = WS_QA + 160 * MiB;
constexpr size_t WS_IQ = 272 * MiB;
constexpr size_t WS_MISC = 288 * MiB;
constexpr size_t WS_KB = 320 * MiB;
constexpr size_t WS_VB = 324 * MiB;
constexpr size_t WS_IKN = 356 * MiB;
constexpr size_t WS_IW = 364 * MiB;
constexpr size_t WS_MASK = 366 * MiB;
constexpr size_t WS_END = 376 * MiB;
constexpr int CW_BAR = 4096;

constexpr int LDS_BYTES = 155648;
constexpr int LDSCTL_OFF = LDS_BYTES - 256;

#define GAS __attribute__((address_space(1)))
#define LAS __attribute__((address_space(3)))
typedef unsigned short bf16;
typedef unsigned v4u __attribute__((ext_vector_type(4)));
typedef float f32x4 __attribute__((ext_vector_type(4)));
typedef GAS unsigned gu32;
#define RLX_AGENT __ATOMIC_RELAXED, __HIP_MEMORY_SCOPE_AGENT
__device__ __forceinline__ unsigned f2bf(float f) { unsigned u = __builtin_bit_cast(unsigned, f); return (u + 0x7fffu + ((u >> 16) & 1u)) >> 16; }
__device__ __forceinline__ unsigned pk2(float lo, float hi) { return f2bf(lo) | (f2bf(hi) << 16); }
__device__ __forceinline__ float bf2f(unsigned short h) { return __builtin_bit_cast(float, (unsigned)h << 16); }
__device__ __forceinline__ float bflo(unsigned w) { return __builtin_bit_cast(float, w << 16); }
__device__ __forceinline__ float bfhi(unsigned w) { return __builtin_bit_cast(float, w & 0xffff0000u); }
__device__ __forceinline__ float wave_sum(float v) {
#pragma unroll
    for (int o = 1; o < 64; o <<= 1) v += __shfl_xor(v, o);
    return v;
}
__device__ __forceinline__ float wave_max(float v) {
#pragma unroll
    for (int o = 1; o < 64; o <<= 1) v = fmaxf(v, __shfl_xor(v, o));
    return v;
}

#define XB_TMO      128
#define XB_XCNT(j)  (256  + 64 * (j))
#define XB_XSUB(j)  (1280 + 64 * (j))
#define XB_XGEN(j)  (2304 + 64 * (j))
#define XB_TOP      3328
#define XB_TOPGEN   3392
#define XCD_BAR_WORDS 3456
#define XB_SPIN_CAP (1u << 18)

__device__ __forceinline__ unsigned xb_ld(unsigned* p)              { return __hip_atomic_load(p, __ATOMIC_RELAXED, __HIP_MEMORY_SCOPE_AGENT); }
__device__ __forceinline__ unsigned xb_add(unsigned* p, unsigned v) { return __hip_atomic_fetch_add(p, v, __ATOMIC_RELAXED, __HIP_MEMORY_SCOPE_AGENT); }
__device__ __forceinline__ unsigned xb_xcc_id() { return (unsigned)__builtin_amdgcn_s_getreg((3 << 11) | 20) & 0xFu; }
#define XB_SPIN(cond, bar) do { unsigned _sp = 0; while (cond) { __builtin_amdgcn_s_sleep(1); \
    if ((++_sp & 255u) == 0u) { if (xb_ld(&(bar)[XB_TMO])) break; if (_sp > XB_SPIN_CAP) { atomicAdd(&(bar)[XB_TMO], 1u); break; } } } } while (0)

struct XcdBarrier {
    unsigned* bar; unsigned x;
    volatile LAS unsigned* st;
};

__device__ __forceinline__ XcdBarrier xcd_barrier_post(unsigned* bar, volatile LAS unsigned* st) {
    XcdBarrier b; b.bar = bar; b.x = xb_xcc_id(); b.st = st;
    if (threadIdx.x == 0) (void)xb_add(&bar[XB_XCNT(b.x)], 1u);
    return b;
}
__device__ __forceinline__ void xcd_barrier_complete(unsigned* bar, unsigned x, unsigned& nloc, unsigned& nx) {
    const unsigned G = gridDim.x * gridDim.y * gridDim.z;
    unsigned sum, cnt, mine, sp = 0u;
    for (;;) {
        sum = 0u; cnt = 0u; mine = 0u;
#pragma unroll
        for (unsigned j = 0; j < 16; ++j) { const unsigned c = xb_ld(&bar[XB_XCNT(j)]); sum += c; cnt += (c > 0u) ? 1u : 0u; mine = (j == x) ? c : mine; }
        if (sum == G) break;
        __builtin_amdgcn_s_sleep(1);
        if ((++sp & 255u) == 0u) { if (xb_ld(&bar[XB_TMO])) break; if (sp > XB_SPIN_CAP) { atomicAdd(&bar[XB_TMO], 1u); break; } }
    }
    nloc = mine > 0u ? mine : 1u; nx = cnt > 0u ? cnt : 1u;
}

__device__ __forceinline__ void xcd_barrier(const XcdBarrier& b) {
    asm volatile("s_waitcnt vmcnt(0)" ::: "memory");
    __syncthreads();
    if (threadIdx.x == 0) {
        unsigned* bar = b.bar;
        __builtin_amdgcn_s_waitcnt(0);
        unsigned nloc = b.st[0], nx = b.st[1];
        if (nloc == 0u) { xcd_barrier_complete(bar, b.x, nloc, nx); b.st[0] = nloc; b.st[1] = nx; }
        const unsigned old = xb_add(&bar[XB_XSUB(b.x)], 1u);
        const unsigned gen = old / nloc;
        if (old + 1u == (gen + 1u) * nloc) {
            __builtin_amdgcn_fence(__ATOMIC_RELEASE, "agent");
            asm volatile("s_waitcnt vmcnt(0)" ::: "memory");
            const unsigned og = xb_add(&bar[XB_TOP], 1u);
            const unsigned tg = og / nx;
            if (og + 1u == (tg + 1u) * nx) xb_add(&bar[XB_TOPGEN], 1u);
            else XB_SPIN(xb_ld(&bar[XB_TOPGEN]) == tg, bar);
            __builtin_amdgcn_fence(__ATOMIC_ACQUIRE, "agent");
            xb_add(&bar[XB_XGEN(b.x)], 1u);
            asm volatile("s_waitcnt vmcnt(0)" ::: "memory");
        } else {
            XB_SPIN(xb_ld(&bar[XB_XGEN(b.x)]) == gen, bar);
            __builtin_amdgcn_fence(__ATOMIC_ACQUIRE, "agent");
            asm volatile("s_waitcnt vmcnt(0)" ::: "memory");
        }
    }
    __syncthreads();
}


struct Ctx {
    const float* x; const int* pos; const float* g_in; const float* w_in; const float* g_kv; const float* w_uk; const float* w_uv; const float* g_ik;
    const float* g_a; const float* g_b; const float* w_out; const float* g_fin;
    float* out; unsigned char* ws;
    int tid, lane, wave, G, gw, NGW;
};

namespace pg8 {
__device__ __forceinline__ unsigned cvt_pk_bf16(float lo, float hi) { unsigned r; asm volatile("v_cvt_pk_bf16_f32 %0, %1, %2" : "=v"(r) : "v"(lo), "v"(hi)); return r; }
struct EpiProj {
    static constexpr bool PERM = true, AFTER_DRAIN = false;
    unsigned char* ws; const float* cs;
    __device__ __forceinline__ void operator()(const f32x4 (&acc)[2][2][4][2], const Unit& u, int wr, int wc, int fr, int fq) const {
        const int pn = u.pn;
        const int row0 = u.pm * BM + wr * 64 + fr;
        if (pn == 13) {
            float* base = (float*)(ws + WS_MISC) + wc * 32 + 8 * fq;
#pragma unroll
            for (int ai = 0; ai < 2; ++ai)
#pragma unroll
                for (int m = 0; m < 4; ++m) { float* rowp = base + (size_t)(row0 + ai * HALF + m * 16) * 256;
#pragma unroll
                    for (int bj = 0; bj < 2; ++bj) { *(f32x4*)(rowp + bj * HALF) = acc[ai][bj][m][0]; *(f32x4*)(rowp + bj * HALF + 4) = acc[ai][bj][m][1]; } }
            return;
        }
        bf16_t* base; int ld;
        if (pn == 12) { base = (bf16_t*)(ws + WS_IQ); ld = 256; }
        else { base = (bf16_t*)(ws + WS_QA + (size_t)(pn >> 1) * (32 * MiB)) + (pn & 1) * 256; ld = 512; }
        const bool rope = (pn < 4) || (pn == 8) || (pn == 9) || (pn == 12);
        const float sc = (pn < 2 || pn == 8 || pn == 9) ? C2 : 1.0f;
        const bool ropew = rope && ((wc & 1) == 0);
        base += wc * 32 + 8 * fq;
#pragma unroll
        for (int ai = 0; ai < 2; ++ai)
#pragma unroll
            for (int m = 0; m < 4; ++m) {
                const int row = row0 + ai * HALF + m * 16;
                bf16_t* rowp = base + (size_t)row * ld;
                f32x4 c0 = {1.f, 1.f, 1.f, 1.f}, c1 = c0, s0 = {0.f, 0.f, 0.f, 0.f}, s1 = s0;
                if (ropew) { const f32x4* cp = (const f32x4*)(cs + (size_t)row * 16); c0 = cp[0]; c1 = cp[1]; s0 = cp[2]; s1 = cp[3]; if (fq == 0) { s0 = -s0; s1 = -s1; } if (fq >= 2) { c0 = (f32x4){1.f, 1.f, 1.f, 1.f}; c1 = c0; s0 = (f32x4){0.f, 0.f, 0.f, 0.f}; s1 = s0; } }
#pragma unroll
                for (int bj = 0; bj < 2; ++bj) {
                    f32x4 v0 = acc[ai][bj][m][0], v1 = acc[ai][bj][m][1];
                    if (ropew) {
                        f32x4 p0, p1;
#pragma unroll
                        for (int e = 0; e < 4; ++e) { p0[e] = __shfl_xor(v0[e], 16); p1[e] = __shfl_xor(v1[e], 16); }
                        v0 = v0 * c0 + p0 * s0; v1 = v1 * c1 + p1 * s1;
                    }
                    v0 = v0 * sc; v1 = v1 * sc;
                    u32x4 w; w.x = cvt_pk_bf16(v0[0], v0[1]); w.y = cvt_pk_bf16(v0[2], v0[3]); w.z = cvt_pk_bf16(v1[0], v1[1]); w.w = cvt_pk_bf16(v1[2], v1[3]);
                    *(u32x4*)(rowp + bj * HALF) = w;
                }
            }
    }
};
struct EpiOut {
    static constexpr bool PERM = false, AFTER_DRAIN = false;
    const float* x; float* out; const float* ssa;
    __device__ __forceinline__ void operator()(const f32x4 (&acc)[2][2][4][2], const Unit& u, int wr, int wc, int fr, int fq) const {
        const int col0 = u.pn * BM + wc * 32 + 4 * fq;
#pragma unroll
        for (int ai = 0; ai < 2; ++ai)
#pragma unroll
            for (int m = 0; m < 4; ++m) {
                const int r = u.pm * BM + ai * HALF + wr * 64 + m * 16 + fr;
                const f32x4 a0 = *(const f32x4*)(ssa + (size_t)r * 8), a1 = *(const f32x4*)(ssa + (size_t)r * 8 + 4);
                const float ss = ((a0[0] + a0[1]) + (a0[2] + a0[3])) + ((a1[0] + a1[1]) + (a1[2] + a1[3]));
                const float rs = 1.0f / sqrtf(ss * (1.0f / 512.0f) + EPS);
                const size_t off = (size_t)r * DM + col0;
#pragma unroll
                for (int bj = 0; bj < 2; ++bj)
#pragma unroll
                    for (int n = 0; n < 2; ++n) { const f32x4 xv = *(const f32x4*)(x + off + bj * HALF + n * 16); *(f32x4*)(out + off + bj * HALF + n * 16) = xv + acc[ai][bj][m][n] * rs; }
            }
    }
};
}

__device__ __forceinline__ void p0_transpose_item(const float* W, int ldw, int srccol0, int nvalid, const float* rowgain, bf16* WT, int K, int n0, int k0, LAS float* scr, int lane) {
#pragma unroll 8
    for (int i = 0; i < 32; ++i) { const int kk = 2 * i + (lane >> 5), n = lane & 31; float v = 0.f; if (n < nvalid) { v = W[(size_t)(k0 + kk) * ldw + srccol0 + n]; if (rowgain) v *= rowgain[k0 + kk]; } scr[kk * 33 + n] = v; }
    asm volatile("s_waitcnt lgkmcnt(0)" ::: "memory");
    const int c = lane & 7;
#pragma unroll
    for (int j = 0; j < 4; ++j) { const int n = (lane >> 3) + 8 * j; const LAS float* s = scr + (8 * c) * 33 + n;
        v4u o; o.x = pk2(s[0 * 33], s[1 * 33]); o.y = pk2(s[2 * 33], s[3 * 33]); o.z = pk2(s[4 * 33], s[5 * 33]); o.w = pk2(s[6 * 33], s[7 * 33]);
        *(GAS v4u*)(WT + (size_t)(n0 + n) * K + k0 + 8 * c) = o; }
    asm volatile("s_waitcnt lgkmcnt(0)" ::: "memory");
}
__device__ __forceinline__ void p0_prologue(const Ctx& C, LAS unsigned char* lds) {
    LAS float* scr = (LAS float*)(lds + C.wave * 16384);
    constexpr int I1 = 16 * (NPROJ / 32), I2 = 16 * (DM / 32);
    for (int it = C.gw; it < I1 + I2; it += C.NGW) {
        if (it < I1) {
            const int kb = it / (NPROJ / 32), nb = it % (NPROJ / 32), n0 = 32 * nb;
            int src;
            if (n0 < 2560) src = n0; else if (n0 < 3072) src = 2688 + (n0 - 2560); else if (n0 < 3328) src = 3200 + (n0 - 3072); else if (n0 < 3456) src = 2560 + (n0 - 3328); else src = n0;
            const int nvalid = (n0 + 32 <= DIN) ? 32 : (n0 < DIN ? DIN - n0 : 0);
            p0_transpose_item(C.w_in, DIN, src, nvalid, nullptr, (bf16*)(C.ws + WS_WIN), DM, n0, 64 * kb, scr, C.lane);
        } else {
            const int r = it - I1, kb = r / (DM / 32), nb = r % (DM / 32);
            const float* gain = (kb < 8) ? C.g_a : (C.g_b - 512);
            p0_transpose_item(C.w_out, DM, 32 * nb, 32, gain, (bf16*)(C.ws + WS_WOUT), DM, 32 * nb, 64 * kb, scr, C.lane);
        }
    }
    for (int m = C.gw; m < M; m += C.NGW) {
        const GAS f32x4* xr = (const GAS f32x4*)(C.x + (size_t)m * DM) + C.lane;
        const GAS f32x4* gr = (const GAS f32x4*)C.g_in + C.lane;
        f32x4 v[4]; float s = 0.f;
#pragma unroll
        for (int j = 0; j < 4; ++j) { v[j] = xr[64 * j]; s += (v[j].x * v[j].x + v[j].y * v[j].y) + (v[j].z * v[j].z + v[j].w * v[j].w); }
        const float rs = 1.0f / sqrtf(wave_sum(s) * (1.0f / DM) + EPS);
        GAS unsigned long long* o8 = (GAS unsigned long long*)((bf16*)(C.ws + WS_XN) + (size_t)m * DM) + C.lane;
#pragma unroll
        for (int j = 0; j < 4; ++j) { const f32x4 g = gr[64 * j]; o8[64 * j] = (unsigned long long)pk2(v[j].x * rs * g.x, v[j].y * rs * g.y) | ((unsigned long long)pk2(v[j].z * rs * g.z, v[j].w * rs * g.w) << 32); }
    }
    for (int e = blockIdx.x * (NWAVES * 64) + C.tid; e < M * 8; e += C.G * NWAVES * 64) {
        const int tok = e >> 3, j = e & 7;
        const float inv = exp2f(-(float)j * (18.931568569324174f / 8.0f));
        const float ang = (float)C.pos[tok] * inv;
        const double rev = (double)ang * 0.15915494309189535;
        const float fr = (float)(rev - rint(rev));
        float* cs = (float*)(C.ws + WS_CS) + (size_t)tok * 16;
        cs[j] = __builtin_amdgcn_cosf(fr); cs[8 + j] = __builtin_amdgcn_sinf(fr);
    }
    for (int e = blockIdx.x * (NWAVES * 64) + C.tid; e < 576 * 128; e += C.G * NWAVES * 64) {
        const int n = e >> 7, c = e & 127;
        const float v = (n < 64) ? C.w_uk[c * 64 + n] : C.w_uv[(size_t)(((n - 64) >> 6) * 128 + c) * 64 + ((n - 64) & 63)];
        ((bf16*)(C.ws + WS_WCAT))[e] = (bf16)f2bf(v);
    }
}

__device__ __forceinline__ void p2_token_local(const Ctx& C, LAS unsigned char* lds) {
    LAS float* ck = (LAS float*)(lds + C.wave * 16384);
    const int lane = C.lane;
    const float* misc = (const float*)(C.ws + WS_MISC);
    const float* cs = (const float*)(C.ws + WS_CS);
    for (int grp = C.gw; grp < M / 8; grp += C.NGW) {
        const int tok0 = grp * 8;
#pragma unroll 1
        for (int tt = 0; tt < 8; ++tt) {
            const int tok = tok0 + tt; const float* mr = misc + (size_t)tok * 256;
            const float a = mr[2 * lane], b = mr[2 * lane + 1];
            const float rs = 1.0f / sqrtf(wave_sum(a * a + b * b) * (1.0f / 128.0f) + EPS);
            ck[tt * 128 + 2 * lane] = a * rs * C.g_kv[2 * lane]; ck[tt * 128 + 2 * lane + 1] = b * rs * C.g_kv[2 * lane + 1];
            const float k = mr[128 + lane];
            const float rk = 1.0f / sqrtf(wave_sum(k * k) * (1.0f / 64.0f) + EPS);
            float kn = k * rk * C.g_ik[lane];
            const float partner = __shfl_xor(kn, 8);
            if (lane < 16) { const float c = cs[(size_t)tok * 16 + (lane & 7)], s = cs[(size_t)tok * 16 + 8 + (lane & 7)]; kn = (lane < 8) ? kn * c - partner * s : kn * c + partner * s; }
            ((bf16*)(C.ws + WS_IKN))[(size_t)tok * 64 + lane] = (bf16)f2bf(kn);
            if (lane < 4) ((float*)(C.ws + WS_IW))[(size_t)tok * 4 + lane] = mr[192 + lane] * 0.0625f;
        }
        asm volatile("s_waitcnt lgkmcnt(0)" ::: "memory");
        float acc[9][8];
#pragma unroll
        for (int i = 0; i < 9; ++i)
#pragma unroll
            for (int t = 0; t < 8; ++t) acc[i][t] = 0.f;
#pragma unroll 2
        for (int c = 0; c < 128; ++c) {
            float w[9]; w[0] = C.w_uk[c * 64 + lane];
#pragma unroll
            for (int h = 0; h < 8; ++h) w[1 + h] = C.w_uv[(size_t)(h * 128 + c) * 64 + lane];
#pragma unroll
            for (int t = 0; t < 8; ++t) { const float a = ck[t * 128 + c];
#pragma unroll
                for (int i = 0; i < 9; ++i) acc[i][t] += a * w[i]; }
        }
#pragma unroll
        for (int t = 0; t < 8; ++t) {
            const int tok = tok0 + t;
            float kb = acc[0][t];
            const float partner = __shfl_xor(kb, 8);
            if (lane < 16) { const float c = cs[(size_t)tok * 16 + (lane & 7)], s = cs[(size_t)tok * 16 + 8 + (lane & 7)]; kb = (lane < 8) ? kb * c - partner * s : kb * c + partner * s; }
            ((bf16*)(C.ws + WS_KB))[(size_t)tok * 64 + lane] = (bf16)f2bf(kb);
#pragma unroll
            for (int h = 0; h < 8; ++h) ((bf16*)(C.ws + WS_VB))[(size_t)tok * 512 + h * 64 + lane] = (bf16)f2bf(acc[1 + h][t]);
        }
        asm volatile("s_waitcnt lgkmcnt(0)" ::: "memory");
    }
}

__device__ __forceinline__ int wave_sum_i32(int v) {
    v += __builtin_amdgcn_update_dpp(0, v, 0xB1, 0xF, 0xF, true);
    v += __builtin_amdgcn_update_dpp(0, v, 0x4E, 0xF, 0xF, true);
    v += __builtin_amdgcn_update_dpp(0, v, 0x141, 0xF, 0xF, true);
    v += __builtin_amdgcn_update_dpp(0, v, 0x140, 0xF, 0xF, true);
    return __builtin_amdgcn_readlane(v, 0) + __builtin_amdgcn_readlane(v, 16) + __builtin_amdgcn_readlane(v, 32) + __builtin_amdgcn_readlane(v, 48);
}
__device__ __forceinline__ void select_topk(const LAS float* srow, int t, unsigned long long* maskrow, int lane) {
    unsigned key[32];
#pragma unroll
    for (int j = 0; j < 32; ++j) { const int s = 64 * j + lane; const unsigned f = __float_as_uint(srow[s]); const unsigned u = (f & 0x80000000u) ? ~f : (f | 0x80000000u); key[j] = (s <= t) ? u : 0u; }
    const int nregs = (t >> 6) + 1;
    unsigned long long myword = 0ull;
    if (t + 1 <= 256) {
#pragma unroll
        for (int j = 0; j < 32; ++j) { const unsigned long long b = __builtin_amdgcn_ballot_w64(key[j] != 0u); if (lane == j) myword = b; }
    } else {
        unsigned T = 0u; bool exact = false;
        for (int bit = 31; bit >= 0; --bit) {
            const unsigned cand = T | (1u << bit);
            int cl = 0;
#pragma unroll
            for (int j = 0; j < 8; ++j) cl += (key[j] >= cand) ? 1 : 0;
            if (nregs > 8) {
#pragma unroll
                for (int j = 8; j < 16; ++j) cl += (key[j] >= cand) ? 1 : 0;
                if (nregs > 16) {
#pragma unroll
                    for (int j = 16; j < 24; ++j) cl += (key[j] >= cand) ? 1 : 0;
                    if (nregs > 24) {
#pragma unroll
                        for (int j = 24; j < 32; ++j) cl += (key[j] >= cand) ? 1 : 0;
                    }
                }
            }
            const int c = wave_sum_i32(cl);
            if (c >= 256) { T = cand; if (c == 256) { exact = true; break; } }
        }
        if (exact) {
#pragma unroll
            for (int j = 0; j < 32; ++j) { const unsigned long long b = __builtin_amdgcn_ballot_w64(key[j] >= T); if (lane == j) myword = b; }
        } else {
            int cgt = 0;
#pragma unroll
            for (int j = 0; j < 32; ++j) cgt += __builtin_popcountll(__builtin_amdgcn_ballot_w64(key[j] > T));
            const int r = 256 - cgt; int running = 0;
            const unsigned long long ltmask = (1ull << lane) - 1ull;
#pragma unroll
            for (int j = 0; j < 32; ++j) {
                const unsigned long long eq = __builtin_amdgcn_ballot_w64(key[j] == T);
                const int pre = running + __builtin_popcountll(eq & ltmask);
                const bool s = (key[j] > T) || (key[j] == T && pre < r);
                const unsigned long long b = __builtin_amdgcn_ballot_w64(s);
                if (lane == j) myword = b;
                running += __builtin_popcountll(eq);
            }
        }
    }
    if (lane < 32) maskrow[lane] = myword;
}
__device__ __forceinline__ void p3_indexer(const Ctx& C, LAS unsigned char* lds) {
    LAS float* scores = (LAS float*)lds;
    LAS float* iql = (LAS float*)(lds + 131072);
    LAS float* iwl = (LAS float*)(lds + 131072 + 16384);
    const bf16* IQ = (const bf16*)(C.ws + WS_IQ); const bf16* IKN = (const bf16*)(C.ws + WS_IKN); const float* IW = (const float*)(C.ws + WS_IW);
    unsigned long long* MASK = (unsigned long long*)(C.ws + WS_MASK);
    for (int unit = blockIdx.x; unit < BATCH * (SEQ / 16); unit += C.G) {
        const int b = unit / (SEQ / 16), t0 = (unit % (SEQ / 16)) * 16; const size_t tokb = (size_t)b * SEQ;
        {
            const int idx = C.tid * 8; const v4u w = *(const GAS v4u*)(IQ + (tokb + t0 + (idx >> 8)) * 256 + (idx & 255));
            LAS float* d = iql + idx; d[0] = bflo(w.x); d[1] = bfhi(w.x); d[2] = bflo(w.y); d[3] = bfhi(w.y); d[4] = bflo(w.z); d[5] = bfhi(w.z); d[6] = bflo(w.w); d[7] = bfhi(w.w);
            if (C.tid < 64) iwl[C.tid] = IW[(tokb + t0) * 4 + C.tid];
        }
        __syncthreads();
        const int nkeys = t0 + 16;
        for (int s = C.tid; s < nkeys; s += NWAVES * 64) {
            float k[64];
            const GAS v4u* kp = (const GAS v4u*)(IKN + (tokb + s) * 64);
#pragma unroll
            for (int i = 0; i < 8; ++i) { const v4u w = kp[i]; k[8 * i] = bflo(w.x); k[8 * i + 1] = bfhi(w.x); k[8 * i + 2] = bflo(w.y); k[8 * i + 3] = bfhi(w.y); k[8 * i + 4] = bflo(w.z); k[8 * i + 5] = bfhi(w.z); k[8 * i + 6] = bflo(w.w); k[8 * i + 7] = bfhi(w.w); }
#pragma unroll 1
            for (int q = 0; q < 16; ++q) {
                float sc = 0.f;
#pragma unroll
                for (int h = 0; h < 4; ++h) {
                    const LAS f32x4* qp = (const LAS f32x4*)(iql + q * 256 + h * 64);
                    float d0 = 0.f, d1 = 0.f;
#pragma unroll
                    for (int i = 0; i < 16; ++i) { const f32x4 qv = qp[i]; d0 += qv.x * k[4 * i] + qv.z * k[4 * i + 2]; d1 += qv.y * k[4 * i + 1] + qv.w * k[4 * i + 3]; }
                    sc += iwl[q * 4 + h] * fmaxf(d0 + d1, 0.f);
                }
                scores[q * 2048 + s] = sc;
            }
        }
        __syncthreads();
#pragma unroll 1
        for (int qq = 0; qq < 2; ++qq) { const int q = C.wave * 2 + qq, t = t0 + q; select_topk(scores + q * 2048, t, MASK + (tokb + t) * 32, C.lane); }
        __syncthreads();
    }
}

__device__ __forceinline__ void p4_mixer_a(const Ctx& C) {
    const bf16* QA = (const bf16*)(C.ws + WS_QA); const bf16* KA = (const bf16*)(C.ws + WS_KA); const bf16* VA = (const bf16*)(C.ws + WS_VA); const bf16* ZA = (const bf16*)(C.ws + WS_ZA);
    bf16* Y = (bf16*)(C.ws + WS_Y); float* SSA = (float*)(C.ws + WS_SSA);
    const int lane = C.lane;
    for (int job = C.gw; job < M * 8; job += C.NGW) {
        const int tok = job >> 3, h = job & 7, b = tok / SEQ, t = tok % SEQ; const size_t tokb = (size_t)b * SEQ;
        float qf[64];
        { const GAS v4u* qp = (const GAS v4u*)(QA + (size_t)tok * 512 + h * 64);
#pragma unroll
          for (int i = 0; i < 8; ++i) { const v4u w = qp[i]; qf[8 * i] = bflo(w.x); qf[8 * i + 1] = bfhi(w.x); qf[8 * i + 2] = bflo(w.y); qf[8 * i + 3] = bfhi(w.y); qf[8 * i + 4] = bflo(w.z); qf[8 * i + 5] = bfhi(w.z); qf[8 * i + 6] = bflo(w.w); qf[8 * i + 7] = bfhi(w.w); } }
        float sv[7]; int pv[7]; float mx = -INFINITY;
#pragma unroll
        for (int i = 0; i < 7; ++i) {
            const int e = lane + 64 * i; int d, j;
            if (e < 129) { d = 1; j = e; } else if (e < 258) { d = 4; j = e - 129; } else { d = 16; j = e - 258; }
            const int p = t - j * d; const bool valid = (e < 387) && (p >= 0);
            float s = -INFINITY;
            if (valid) { const GAS v4u* kp = (const GAS v4u*)(KA + (tokb + p) * 512 + h * 64); float a0 = 0.f, a1 = 0.f;
#pragma unroll
                for (int c = 0; c < 8; ++c) { const v4u w = kp[c]; a0 += qf[8 * c] * bflo(w.x) + qf[8 * c + 2] * bflo(w.y) + qf[8 * c + 4] * bflo(w.z) + qf[8 * c + 6] * bflo(w.w); a1 += qf[8 * c + 1] * bfhi(w.x) + qf[8 * c + 3] * bfhi(w.y) + qf[8 * c + 5] * bfhi(w.z) + qf[8 * c + 7] * bfhi(w.w); }
                s = a0 + a1; }
            sv[i] = s; pv[i] = valid ? p : 0; mx = fmaxf(mx, s);
        }
        mx = wave_max(mx);
        float lsum = 0.f;
#pragma unroll
        for (int i = 0; i < 7; ++i) { sv[i] = exp2f(sv[i] - mx); lsum += sv[i]; }
        lsum = wave_sum(lsum);
        float o = 0.f;
        const bf16* vcol = VA + tokb * 512 + h * 64 + lane;
#pragma unroll
        for (int i = 0; i < 7; ++i) {
            const int cnt = (i < 6) ? 64 : 3;
#pragma unroll 8
            for (int l2 = 0; l2 < cnt; ++l2) { const float pp = __builtin_bit_cast(float, __builtin_amdgcn_readlane(__builtin_bit_cast(int, sv[i]), l2)); const int ps = __builtin_amdgcn_readlane(pv[i], l2);
                o += pp * bf2f(vcol[(size_t)ps * 512]); }
        }
        o = o / lsum;
        const float z = bf2f(ZA[(size_t)tok * 512 + h * 64 + lane]);
        const float v = o * z / (1.0f + __expf(-z));
        const float ss = wave_sum(v * v);
        if (lane == 0) SSA[(size_t)tok * 8 + h] = ss;
        Y[(size_t)tok * DM + h * 64 + lane] = (bf16)f2bf(v);
    }
}

__device__ __forceinline__ void p5_mixer_b(const Ctx& C, LAS unsigned char* lds) {
    const bf16* QB = (const bf16*)(C.ws + WS_QB); const bf16* KB = (const bf16*)(C.ws + WS_KB); const bf16* VB = (const bf16*)(C.ws + WS_VB); const bf16* ZB = (const bf16*)(C.ws + WS_ZB);
    const unsigned long long* MASK = (const unsigned long long*)(C.ws + WS_MASK);
    bf16* Y = (bf16*)(C.ws + WS_Y); const float* SSA = (const float*)(C.ws + WS_SSA);
    LAS float* red = (LAS float*)lds;
    const int lane = C.lane, h = C.wave;
    for (int tok = blockIdx.x; tok < M; tok += C.G) {
        const int b = tok / SEQ, t = tok % SEQ; const size_t tokb = (size_t)b * SEQ;
        float qf[64];
        { const GAS v4u* qp = (const GAS v4u*)(QB + (size_t)tok * 512 + h * 64);
#pragma unroll
          for (int i = 0; i < 8; ++i) { const v4u w = qp[i]; qf[8 * i] = bflo(w.x); qf[8 * i + 1] = bfhi(w.x); qf[8 * i + 2] = bflo(w.y); qf[8 * i + 3] = bfhi(w.y); qf[8 * i + 4] = bflo(w.z); qf[8 * i + 5] = bfhi(w.z); qf[8 * i + 6] = bflo(w.w); qf[8 * i + 7] = bfhi(w.w); } }
        const int nw = (t >> 6) + 1;
        float sv[32]; float mx = -INFINITY;
#pragma unroll
        for (int j = 0; j < 32; ++j) {
            float s = -INFINITY;
            if (j < nw) {
                const unsigned long long w = MASK[(size_t)tok * 32 + j];
                if ((w >> lane) & 1ull) { const GAS v4u* kp = (const GAS v4u*)(KB + (tokb + 64 * j + lane) * 64); float a0 = 0.f, a1 = 0.f;
#pragma unroll
                    for (int c = 0; c < 8; ++c) { const v4u x = kp[c]; a0 += qf[8 * c] * bflo(x.x) + qf[8 * c + 2] * bflo(x.y) + qf[8 * c + 4] * bflo(x.z) + qf[8 * c + 6] * bflo(x.w); a1 += qf[8 * c + 1] * bfhi(x.x) + qf[8 * c + 3] * bfhi(x.y) + qf[8 * c + 5] * bfhi(x.z) + qf[8 * c + 7] * bfhi(x.w); }
                    s = a0 + a1; }
            }
            sv[j] = s; mx = fmaxf(mx, s);
        }
        mx = wave_max(mx);
        float lsum = 0.f;
#pragma unroll
        for (int j = 0; j < 32; ++j) { sv[j] = exp2f(sv[j] - mx); lsum += sv[j]; }
        lsum = wave_sum(lsum);
        float o = 0.f;
        const bf16* vcol = VB + tokb * 512 + h * 64 + lane;
#pragma unroll
        for (int j = 0; j < 32; ++j) {
            if (j < nw) {
                const unsigned long long wv = MASK[(size_t)tok * 32 + j];
                unsigned wlo = __builtin_amdgcn_readfirstlane((unsigned)wv), whi = __builtin_amdgcn_readfirstlane((unsigned)(wv >> 32));
                unsigned long long w = ((unsigned long long)whi << 32) | wlo;
                while (w) { const int l2 = __builtin_ctzll(w); w &= w - 1ull;
                    const float pp = __builtin_bit_cast(float, __builtin_amdgcn_readlane(__builtin_bit_cast(int, sv[j]), l2));
                    o += pp * bf2f(vcol[(size_t)(64 * j + l2) * 512]); }
            }
        }
        o = o / lsum;
        const float z = bf2f(ZB[(size_t)tok * 512 + h * 64 + lane]);
        const float v = o * z / (1.0f + __expf(-z));
        const float ss = wave_sum(v * v);
        if (lane == 0) red[h] = ss;
        __syncthreads();
        float ssb = 0.f, ssa = 0.f;
#pragma unroll
        for (int i = 0; i < 8; ++i) { ssb += red[i]; ssa += SSA[(size_t)tok * 8 + i]; }
        const float rsb = 1.0f / sqrtf(ssb * (1.0f / 512.0f) + EPS), rsa = 1.0f / sqrtf(ssa * (1.0f / 512.0f) + EPS);
        Y[(size_t)tok * DM + 512 + h * 64 + lane] = (bf16)f2bf(v * rsb / rsa);
        __syncthreads();
    }
}


typedef short bf16x8 __attribute__((ext_vector_type(8)));
typedef short s16x4 __attribute__((ext_vector_type(4)));
typedef float f32x16 __attribute__((ext_vector_type(16)));
typedef unsigned u32x2 __attribute__((ext_vector_type(2)));
struct AttnState { f32x16 o[2]; float m, l; };
__device__ __forceinline__ float swap_max(float v) { auto rr = __builtin_amdgcn_permlane32_swap(__float_as_uint(v), __float_as_uint(v), false, false); return fmaxf(__uint_as_float(rr[0]), __uint_as_float(rr[1])); }
__device__ __forceinline__ float swap_sum(float v) { auto rr = __builtin_amdgcn_permlane32_swap(__float_as_uint(v), __float_as_uint(v), false, false); return __uint_as_float(rr[0]) + __uint_as_float(rr[1]); }
__device__ __forceinline__ unsigned cvtpk(float lo, float hi) { unsigned r; asm volatile("v_cvt_pk_bf16_f32 %0, %1, %2" : "=v"(r) : "v"(lo), "v"(hi)); return r; }
__device__ __forceinline__ s16x4 vtr(const LAS unsigned char* p) { typedef short v4i16_t __attribute__((ext_vector_type(4))); return __builtin_bit_cast(s16x4, __builtin_amdgcn_ds_read_tr16_b64_v4i16((LAS v4i16_t*)p)); }
template <int NKT, class MaskF>
__device__ __forceinline__ void attn_step(AttnState& S, const bf16x8 (&qf)[4], const bf16x8 (&kf)[NKT][4], const LAS unsigned char* vrd, const MaskF& maskf) {
    f32x16 st[NKT];
#pragma unroll
    for (int p = 0; p < NKT; ++p) {
        st[p] = (f32x16){0.f, 0.f, 0.f, 0.f, 0.f, 0.f, 0.f, 0.f, 0.f, 0.f, 0.f, 0.f, 0.f, 0.f, 0.f, 0.f};
#pragma unroll
        for (int s = 0; s < 4; ++s) st[p] = __builtin_amdgcn_mfma_f32_32x32x16_bf16(kf[p][s], qf[s], st[p], 0, 0, 0);
    }
    float mx = -INFINITY;
#pragma unroll
    for (int p = 0; p < NKT; ++p)
#pragma unroll
        for (int r = 0; r < 16; ++r) { if (!maskf(p, r)) st[p][r] = -INFINITY; mx = fmaxf(mx, st[p][r]); }
    mx = swap_max(mx);
    const float m_new = fmaxf(S.m, mx);
    const float m_use = (m_new == -INFINITY) ? 0.f : m_new;
    const float alpha = __builtin_amdgcn_exp2f(S.m - m_use);
    S.m = m_new;
    float rs = 0.f;
#pragma unroll
    for (int p = 0; p < NKT; ++p)
#pragma unroll
        for (int r = 0; r < 16; ++r) { st[p][r] = __builtin_amdgcn_exp2f(st[p][r] - m_use); rs += st[p][r]; }
    S.l = S.l * alpha + rs;
#pragma unroll
    for (int r = 0; r < 16; ++r) { S.o[0][r] *= alpha; S.o[1][r] *= alpha; }
#pragma unroll
    for (int p = 0; p < NKT; ++p)
#pragma unroll
        for (int s2 = 0; s2 < 2; ++s2) {
            v4u pw; pw.x = cvtpk(st[p][8 * s2 + 0], st[p][8 * s2 + 1]); pw.y = cvtpk(st[p][8 * s2 + 2], st[p][8 * s2 + 3]); pw.z = cvtpk(st[p][8 * s2 + 4], st[p][8 * s2 + 5]); pw.w = cvtpk(st[p][8 * s2 + 6], st[p][8 * s2 + 7]);
            const bf16x8 pb = __builtin_bit_cast(bf16x8, pw);
#pragma unroll
            for (int n = 0; n < 2; ++n) {
                const s16x4 lo = vtr(vrd + (4 * p + 2 * s2) * 1024 + n * 512), hi4 = vtr(vrd + (4 * p + 2 * s2 + 1) * 1024 + n * 512);
                const bf16x8 va = (bf16x8){lo[0], lo[1], lo[2], lo[3], hi4[0], hi4[1], hi4[2], hi4[3]};
                S.o[n] = __builtin_amdgcn_mfma_f32_32x32x16_bf16(va, pb, S.o[n], 0, 0, 0);
            }
        }
}


struct StageAddr { LAS unsigned char* kwr0; LAS unsigned char* kwr1; const LAS unsigned char* krd[4]; LAS unsigned char* vwr; const LAS unsigned char* vrd; };
__device__ __forceinline__ StageAddr make_stage(LAS unsigned char* buf, int lane) {
    StageAddr A; const int r = lane & 31, hi = lane >> 5, k7 = lane >> 3, c = lane & 7;
    A.kwr0 = buf + k7 * 128 + ((c ^ (k7 >> 1)) * 16);
    A.kwr1 = buf + k7 * 128 + ((c ^ (k7 >> 1) ^ 4) * 16);
#pragma unroll
    for (int s = 0; s < 4; ++s) A.krd[s] = buf + r * 128 + (((2 * s + hi) ^ ((r >> 1) & 7)) * 16);
    A.vwr = buf + (lane >> 3) * 64 + ((lane & 7) >> 2) * 512 + (lane & 3) * 16;
    A.vrd = buf + (4 * hi + ((lane & 15) >> 2)) * 64 + ((lane >> 4) & 1) * 32 + (lane & 3) * 8;
    return A;
}
template <int NKT, class MaskF, class F1, class F2>
__device__ __forceinline__ void attn_step2(AttnState& S, const bf16x8 (&qf)[4], v4u (&kreg)[8], v4u (&vreg)[8], const StageAddr& A, const MaskF& maskf, const F1& after_k, const F2& after_v) {
#pragma unroll
    for (int i = 0; i < 4 * NKT; ++i) *(LAS v4u*)(((i & 1) ? A.kwr1 : A.kwr0) + i * 1024) = kreg[i];
    bf16x8 kf[NKT][4];
#pragma unroll
    for (int p = 0; p < NKT; ++p)
#pragma unroll
        for (int s = 0; s < 4; ++s) kf[p][s] = *(const LAS bf16x8*)(A.krd[s] + p * 4096);
    f32x16 st[NKT];
#pragma unroll
    for (int p = 0; p < NKT; ++p) {
        st[p] = (f32x16){0.f, 0.f, 0.f, 0.f, 0.f, 0.f, 0.f, 0.f, 0.f, 0.f, 0.f, 0.f, 0.f, 0.f, 0.f, 0.f};
#pragma unroll
        for (int s = 0; s < 4; ++s) st[p] = __builtin_amdgcn_mfma_f32_32x32x16_bf16(kf[p][s], qf[s], st[p], 0, 0, 0);
    }
#pragma unroll
    for (int i = 0; i < 4 * NKT; ++i) *(LAS v4u*)(A.vwr + i * 1024) = vreg[i];
    after_k();
    after_v();
    float mx = -INFINITY;
#pragma unroll
    for (int p = 0; p < NKT; ++p)
#pragma unroll
        for (int r = 0; r < 16; ++r) { if (!maskf(p, r)) st[p][r] = -INFINITY; mx = fmaxf(mx, st[p][r]); }
    mx = swap_max(mx);
    const float m_new = fmaxf(S.m, mx);
    const float m_use = (m_new == -INFINITY) ? 0.f : m_new;
    const float alpha = __builtin_amdgcn_exp2f(S.m - m_use);
    S.m = m_new;
    float rs = 0.f;
#pragma unroll
    for (int p = 0; p < NKT; ++p)
#pragma unroll
        for (int r = 0; r < 16; ++r) { st[p][r] = __builtin_amdgcn_exp2f(st[p][r] - m_use); rs += st[p][r]; }
    S.l = S.l * alpha + rs;
#pragma unroll
    for (int r = 0; r < 16; ++r) { S.o[0][r] *= alpha; S.o[1][r] *= alpha; }
#pragma unroll
    for (int p = 0; p < NKT; ++p)
#pragma unroll
        for (int s2 = 0; s2 < 2; ++s2) {
            v4u pw; pw.x = cvtpk(st[p][8 * s2 + 0], st[p][8 * s2 + 1]); pw.y = cvtpk(st[p][8 * s2 + 2], st[p][8 * s2 + 3]); pw.z = cvtpk(st[p][8 * s2 + 4], st[p][8 * s2 + 5]); pw.w = cvtpk(st[p][8 * s2 + 6], st[p][8 * s2 + 7]);
            const bf16x8 pb = __builtin_bit_cast(bf16x8, pw);
#pragma unroll
            for (int n = 0; n < 2; ++n) {
                const s16x4 lo = vtr(A.vrd + (4 * p + 2 * s2) * 1024 + n * 512), hi4 = vtr(A.vrd + (4 * p + 2 * s2 + 1) * 1024 + n * 512);
                const bf16x8 va = (bf16x8){lo[0], lo[1], lo[2], lo[3], hi4[0], hi4[1], hi4[2], hi4[3]};
                S.o[n] = __builtin_amdgcn_mfma_f32_32x32x16_bf16(va, pb, S.o[n], 0, 0, 0);
            }
        }
}

__device__ __forceinline__ void p5_mixer_b_mfma(const Ctx& C, LAS unsigned char* lds) {
    const bf16* QB = (const bf16*)(C.ws + WS_QB); const bf16* KB = (const bf16*)(C.ws + WS_KB); const bf16* VB = (const bf16*)(C.ws + WS_VB); const bf16* ZB = (const bf16*)(C.ws + WS_ZB);
    const unsigned long long* MASK = (const unsigned long long*)(C.ws + WS_MASK);
    bf16* Y = (bf16*)(C.ws + WS_Y); const float* SSA = (const float*)(C.ws + WS_SSA);
    const int lane = C.lane, r = lane & 31, hi = lane >> 5, head = C.wave;
    LAS float* red = (LAS float*)(lds + 65536);
    const StageAddr A = make_stage(lds + C.wave * 8192, lane);
    for (int up = blockIdx.x; up < BATCH * 32; up += C.G) {
#pragma unroll 1
        for (int half = 0; half < 2; ++half) {
            const int b = up >> 5, qi = half ? 63 - (up & 31) : (up & 31);
            const size_t tokb = (size_t)b * SEQ; const int q0 = 32 * qi, nkt = (qi >> 1) + 1;
            const size_t qtok = tokb + q0 + r;
            bf16x8 qf[4];
#pragma unroll
            for (int s = 0; s < 4; ++s) qf[s] = *(const bf16x8*)(QB + qtok * 512 + head * 64 + 16 * s + 8 * hi);
            const unsigned long long* mrow = MASK + qtok * 32;
            AttnState S; S.m = -INFINITY; S.l = 0.f;
#pragma unroll
            for (int i = 0; i < 16; ++i) { S.o[0][i] = 0.f; S.o[1][i] = 0.f; }
            v4u kreg[8], vreg[8]; unsigned long long wn;
            {
                const bf16* kp = KB + (tokb + (lane >> 3)) * 64 + (lane & 7) * 8;
#pragma unroll
                for (int i = 0; i < 8; ++i) kreg[i] = *(const v4u*)(kp + (size_t)i * 8 * 64);
                const bf16* vp = VB + (tokb + (lane >> 3)) * 512 + head * 64 + (lane & 7) * 8;
#pragma unroll
                for (int i = 0; i < 8; ++i) vreg[i] = *(const v4u*)(vp + (size_t)i * 8 * 512);
                wn = mrow[0];
            }
#pragma unroll 1
            for (int kt = 0; kt < nkt; ++kt) {
                const unsigned long long wc = wn;
                const unsigned wlo = (unsigned)(wc >> (4 * hi)), whi = (unsigned)(wc >> (32 + 4 * hi));
                auto maskf = [&](int p, int reg) -> bool { return (((p ? whi : wlo) >> ((reg & 3) + 8 * (reg >> 2))) & 1u) != 0u; };
                const bool more = kt + 1 < nkt;
                auto after_k = [&]() { if (more) { const bf16* kp = KB + (tokb + 64 * (kt + 1) + (lane >> 3)) * 64 + (lane & 7) * 8;
#pragma unroll
                    for (int i = 0; i < 8; ++i) kreg[i] = *(const v4u*)(kp + (size_t)i * 8 * 64);
                    wn = mrow[kt + 1]; } };
                auto after_v = [&]() { if (more) { const bf16* vp = VB + (tokb + 64 * (kt + 1) + (lane >> 3)) * 512 + head * 64 + (lane & 7) * 8;
#pragma unroll
                    for (int i = 0; i < 8; ++i) vreg[i] = *(const v4u*)(vp + (size_t)i * 8 * 512); } };
                attn_step2<2>(S, qf, kreg, vreg, A, maskf, after_k, after_v);
            }
            const float linv = 1.0f / swap_sum(S.l);
            float ss = 0.f; float vv[2][16];
#pragma unroll
            for (int n = 0; n < 2; ++n)
#pragma unroll
                for (int g = 0; g < 4; ++g) {
                    const u32x2 zw = *(const u32x2*)(ZB + qtok * 512 + head * 64 + 32 * n + 8 * g + 4 * hi);
                    const float z[4] = {bflo(zw.x), bfhi(zw.x), bflo(zw.y), bfhi(zw.y)};
#pragma unroll
                    for (int e = 0; e < 4; ++e) { const float o = S.o[n][4 * g + e] * linv; const float v = o * z[e] / (1.0f + __expf(-z[e])); vv[n][4 * g + e] = v; ss += v * v; }
                }
            ss = swap_sum(ss);
            if (hi == 0) red[head * 32 + r] = ss;
            __syncthreads();
            float ssb = 0.f;
#pragma unroll
            for (int w = 0; w < 8; ++w) ssb += red[w * 32 + r];
            const f32x4 a0 = *(const f32x4*)(SSA + qtok * 8), a1 = *(const f32x4*)(SSA + qtok * 8 + 4);
            const float ssa = ((a0[0] + a0[1]) + (a0[2] + a0[3])) + ((a1[0] + a1[1]) + (a1[2] + a1[3]));
            const float scale = sqrtf(ssa * (1.0f / 512.0f) + EPS) / sqrtf(ssb * (1.0f / 512.0f) + EPS);
#pragma unroll
            for (int n = 0; n < 2; ++n)
#pragma unroll
                for (int g = 0; g < 4; ++g) {
                    u32x2 w; w.x = cvtpk(vv[n][4 * g] * scale, vv[n][4 * g + 1] * scale); w.y = cvtpk(vv[n][4 * g + 2] * scale, vv[n][4 * g + 3] * scale);
                    *(u32x2*)(Y + qtok * DM + 512 + head * 64 + 32 * n + 8 * g + 4 * hi) = w;
                }
            __syncthreads();
        }
    }
}


__device__ __forceinline__ void p4_mixer_a_mfma(const Ctx& C, LAS unsigned char* lds) {
    const bf16* QA = (const bf16*)(C.ws + WS_QA); const bf16* KA = (const bf16*)(C.ws + WS_KA); const bf16* VA = (const bf16*)(C.ws + WS_VA); const bf16* ZA = (const bf16*)(C.ws + WS_ZA);
    bf16* Y = (bf16*)(C.ws + WS_Y); float* SSA = (float*)(C.ws + WS_SSA);
    const int lane = C.lane, r = lane & 31, hi = lane >> 5, w = C.wave;
    const StageAddr A = make_stage(lds + w * 8192, lane);
    LAS float* OST = (LAS float*)(lds + 65536);
    LAS float* MST = (LAS float*)(lds + 65536 + 69632);
    LAS float* LST = MST + 256;
    for (int unit = blockIdx.x; unit < BATCH * 64; unit += C.G) {
        const int b = unit >> 6, c = (unit >> 3) & 7, head = unit & 7, t0 = 256 * c; const size_t tokb = (size_t)b * SEQ;
        const bf16* Kh = KA + tokb * 512 + head * 64; const bf16* Vh = VA + tokb * 512 + head * 64;
#pragma unroll 1
        for (int jj = 0; jj < 4; ++jj) {
            if (jj == 1 || jj == 2) __syncthreads();
            int ld, rr, j0, nq;
            if (jj == 0) { ld = 0; rr = 0; j0 = t0 + 32 * w; nq = 32; }
            else if (jj == 1) { ld = 2; rr = w & 3; j0 = (t0 >> 2) + 32 * (w >> 2); nq = 32; }
            else { ld = 4; rr = 2 * w + (jj - 2); j0 = t0 >> 4; nq = 16; }
            const bool rowok = r < nq;
            const int jq = j0 + (rowok ? r : nq - 1);
            const int qpos = (jq << ld) + rr, lrow = qpos - t0;
            const size_t qtok = tokb + qpos;
            bf16x8 qf[4];
#pragma unroll
            for (int s = 0; s < 4; ++s) qf[s] = *(const bf16x8*)(QA + qtok * 512 + head * 64 + 16 * s + 8 * hi);
            AttnState S;
            if (jj == 0) {
                S.m = -INFINITY; S.l = 0.f;
#pragma unroll
                for (int i = 0; i < 16; ++i) { S.o[0][i] = 0.f; S.o[1][i] = 0.f; }
            } else {
                S.m = MST[lrow]; S.l = LST[hi * 256 + lrow];
#pragma unroll
                for (int n = 0; n < 2; ++n)
#pragma unroll
                    for (int g = 0; g < 4; ++g) { const f32x4 v = *(const LAS f32x4*)(OST + lrow * 68 + 32 * n + 8 * g + 4 * hi); S.o[n][4 * g] = v[0]; S.o[n][4 * g + 1] = v[1]; S.o[n][4 * g + 2] = v[2]; S.o[n][4 * g + 3] = v[3]; }
            }
            const int ks = j0 - 128;
            const unsigned lim = (unsigned)(jq < 128 ? jq : 128);
            const int dq0 = rowok ? (jq - ks - 4 * hi) : -100000;
            const bool act0 = (ks + 63 >= 0), act1 = (ks + 127 >= 0);
            v4u kreg[8], vreg[8];
            const char* Khc = (const char*)Kh; const char* Vhc = (const char*)Vh;
            auto rowoff = [&](int i, int ii) -> unsigned { int jk = ks + 64 * i + 8 * ii + (lane >> 3); jk = jk < 0 ? 0 : jk; int ps = (jk << ld) + rr; ps = ps > SEQ - 1 ? SEQ - 1 : ps; return (unsigned)ps * 1024u + (unsigned)(lane & 7) * 16u; };
            const int i0 = act0 ? 0 : (act1 ? 1 : 2);
#pragma unroll
            for (int ii = 0; ii < 8; ++ii) { const unsigned o = rowoff(i0, ii); kreg[ii] = *(const v4u*)(Khc + o); vreg[ii] = *(const v4u*)(Vhc + o); }
#pragma unroll 1
            for (int i = i0; i < 3; ++i) {
                const int dq = dq0 - 64 * i;
                auto maskf = [&](int p, int reg) -> bool { return (unsigned)(dq - 32 * p - ((reg & 3) + 8 * (reg >> 2))) <= lim; };
                const bool more = i + 1 < 3;
                auto after_k = [&]() { if (more) {
#pragma unroll
                    for (int ii = 0; ii < 8; ++ii) kreg[ii] = *(const v4u*)(Khc + rowoff(i + 1, ii)); } };
                auto after_v = [&]() { if (more) {
#pragma unroll
                    for (int ii = 0; ii < 8; ++ii) vreg[ii] = *(const v4u*)(Vhc + rowoff(i + 1, ii)); } };
                attn_step2<2>(S, qf, kreg, vreg, A, maskf, after_k, after_v);
            }
            if (jj < 2) {
                if (hi == 0) MST[lrow] = S.m;
                LST[hi * 256 + lrow] = S.l;
#pragma unroll
                for (int n = 0; n < 2; ++n)
#pragma unroll
                    for (int g = 0; g < 4; ++g) *(LAS f32x4*)(OST + lrow * 68 + 32 * n + 8 * g + 4 * hi) = (f32x4){S.o[n][4 * g], S.o[n][4 * g + 1], S.o[n][4 * g + 2], S.o[n][4 * g + 3]};
            } else {
                const float linv = 1.0f / swap_sum(S.l);
                float ss = 0.f; float vv[2][16];
#pragma unroll
                for (int n = 0; n < 2; ++n)
#pragma unroll
                    for (int g = 0; g < 4; ++g) {
                        const u32x2 zw = *(const u32x2*)(ZA + qtok * 512 + head * 64 + 32 * n + 8 * g + 4 * hi);
                        const float z[4] = {bflo(zw.x), bfhi(zw.x), bflo(zw.y), bfhi(zw.y)};
#pragma unroll
                        for (int e = 0; e < 4; ++e) { const float o = S.o[n][4 * g + e] * linv; const float v = o * z[e] / (1.0f + __expf(-z[e])); vv[n][4 * g + e] = v; ss += v * v; }
                    }
                ss = swap_sum(ss);
                if (rowok) {
                    if (hi == 0) SSA[qtok * 8 + head] = ss;
#pragma unroll
                    for (int n = 0; n < 2; ++n)
#pragma unroll
                        for (int g = 0; g < 4; ++g) { u32x2 wv; wv.x = cvtpk(vv[n][4 * g], vv[n][4 * g + 1]); wv.y = cvtpk(vv[n][4 * g + 2], vv[n][4 * g + 3]); *(u32x2*)(Y + qtok * DM + head * 64 + 32 * n + 8 * g + 4 * hi) = wv; }
                }
            }
        }
        __syncthreads();
    }
}


__device__ __forceinline__ void p3_indexer_mfma(const Ctx& C, LAS unsigned char* lds) {
    constexpr int SROW = 2052;
    LAS float* scores = (LAS float*)lds;
    const bf16* IQ = (const bf16*)(C.ws + WS_IQ); const bf16* IKN = (const bf16*)(C.ws + WS_IKN); const float* IW = (const float*)(C.ws + WS_IW);
    unsigned long long* MASK = (unsigned long long*)(C.ws + WS_MASK);
    const int lane = C.lane, q = lane & 15, g = lane >> 4, w = C.wave;
    int k = 0;
    for (int u = blockIdx.x; u < BATCH * 128; u += C.G, ++k) {
        const int b = u >> 7, q1 = u & 127, qt = (k & 1) ? 127 - q1 : q1, t0 = qt * 16; const size_t tokb = (size_t)b * SEQ;
        bf16x8 bq[4][2];
#pragma unroll
        for (int h = 0; h < 4; ++h)
#pragma unroll
            for (int ks = 0; ks < 2; ++ks) bq[h][ks] = *(const bf16x8*)(IQ + (tokb + t0 + q) * 256 + h * 64 + 32 * ks + 8 * g);
        const f32x4 wq = *(const f32x4*)(IW + (tokb + t0 + q) * 4);
        const int ntiles = qt + 1;
#pragma unroll 1
        for (int tl0 = w; tl0 < ntiles; tl0 += 4 * NWAVES) {
            bf16x8 a0[4], a1[4];
#pragma unroll
            for (int x = 0; x < 4; ++x) { int tl = tl0 + 8 * x; tl = tl < ntiles ? tl : ntiles - 1; const bf16* kp = IKN + (tokb + 16 * tl + q) * 64 + 8 * g; a0[x] = *(const bf16x8*)kp; a1[x] = *(const bf16x8*)(kp + 32); }
#pragma unroll
            for (int x = 0; x < 4; ++x) {
                const int tl = tl0 + 8 * x;
                f32x4 sc = {0.f, 0.f, 0.f, 0.f};
#pragma unroll
                for (int h = 0; h < 4; ++h) {
                    f32x4 acc = {0.f, 0.f, 0.f, 0.f};
                    acc = __builtin_amdgcn_mfma_f32_16x16x32_bf16(a0[x], bq[h][0], acc, 0, 0, 0);
                    acc = __builtin_amdgcn_mfma_f32_16x16x32_bf16(a1[x], bq[h][1], acc, 0, 0, 0);
#pragma unroll
                    for (int e = 0; e < 4; ++e) sc[e] += wq[h] * fmaxf(acc[e], 0.f);
                }
                if (tl < ntiles) *(LAS f32x4*)(scores + q * SROW + 16 * tl + 4 * g) = sc;
            }
        }
        __syncthreads();
#pragma unroll 1
        for (int qq = 0; qq < (REPEAT_PHASE == 30 ? 4 : 2); ++qq) { const int qi = w * 2 + (qq & 1), t = t0 + qi; select_topk(scores + qi * SROW, t, MASK + (tokb + t) * 32, lane); }
        __syncthreads();
    }
}


__device__ __forceinline__ void p2_token_local_mfma(const Ctx& C) {
    const int lane = C.lane, r = lane & 31, hi = lane >> 5;
    const float* misc = (const float*)(C.ws + WS_MISC);
    const float* cs = (const float*)(C.ws + WS_CS);
    const bf16* WCAT = (const bf16*)(C.ws + WS_WCAT);
    for (int tok = C.gw; tok < M; tok += C.NGW) {
        const float* mr = misc + (size_t)tok * 256;
        const float k = mr[128 + lane];
        const float rk = 1.0f / sqrtf(wave_sum(k * k) * (1.0f / 64.0f) + EPS);
        float kn = k * rk * C.g_ik[lane];
        const float partner = __shfl_xor(kn, 8);
        if (lane < 16) { const float c = cs[(size_t)tok * 16 + (lane & 7)], sn = cs[(size_t)tok * 16 + 8 + (lane & 7)]; kn = (lane < 8) ? kn * c - partner * sn : kn * c + partner * sn; }
        ((bf16*)(C.ws + WS_IKN))[(size_t)tok * 64 + lane] = (bf16)f2bf(kn);
        if (lane < 4) ((float*)(C.ws + WS_IW))[(size_t)tok * 4 + lane] = mr[192 + lane] * 0.0625f;
    }
    for (int u = C.gw; u < (M / 32) * 2; u += C.NGW) {
        const int tok = 32 * (u >> 1) + r, half = u & 1;
        const float* mr = misc + (size_t)tok * 256 + 8 * hi;
        f32x4 a[8][2]; float ss = 0.f;
#pragma unroll
        for (int s = 0; s < 8; ++s) { a[s][0] = *(const f32x4*)(mr + 16 * s); a[s][1] = *(const f32x4*)(mr + 16 * s + 4);
            ss += (a[s][0][0] * a[s][0][0] + a[s][0][1] * a[s][0][1]) + (a[s][0][2] * a[s][0][2] + a[s][0][3] * a[s][0][3]) + (a[s][1][0] * a[s][1][0] + a[s][1][1] * a[s][1][1]) + (a[s][1][2] * a[s][1][2] + a[s][1][3] * a[s][1][3]); }
        ss = swap_sum(ss);
        const float rs = 1.0f / sqrtf(ss * (1.0f / 128.0f) + EPS);
        bf16x8 bfr[8];
#pragma unroll
        for (int s = 0; s < 8; ++s) { const f32x4 g0 = *(const f32x4*)(C.g_kv + 16 * s + 8 * hi), g1 = *(const f32x4*)(C.g_kv + 16 * s + 8 * hi + 4);
            v4u w; w.x = cvtpk(a[s][0][0] * rs * g0[0], a[s][0][1] * rs * g0[1]); w.y = cvtpk(a[s][0][2] * rs * g0[2], a[s][0][3] * rs * g0[3]); w.z = cvtpk(a[s][1][0] * rs * g1[0], a[s][1][1] * rs * g1[1]); w.w = cvtpk(a[s][1][2] * rs * g1[2], a[s][1][3] * rs * g1[3]);
            bfr[s] = __builtin_bit_cast(bf16x8, w); }
#pragma unroll 1
        for (int tile = 0; tile < 9; ++tile) {
            const int n0 = 32 * (9 * half + tile);
            f32x16 acc = {0.f, 0.f, 0.f, 0.f, 0.f, 0.f, 0.f, 0.f, 0.f, 0.f, 0.f, 0.f, 0.f, 0.f, 0.f, 0.f};
            const bf16* wp = WCAT + (size_t)(n0 + r) * 128 + 8 * hi;
#pragma unroll
            for (int s = 0; s < 8; ++s) { const bf16x8 afr = *(const bf16x8*)(wp + 16 * s); acc = __builtin_amdgcn_mfma_f32_32x32x16_bf16(afr, bfr[s], acc, 0, 0, 0); }
            if (n0 == 0) {
                const f32x4 cv = *(const f32x4*)(cs + (size_t)tok * 16 + 4 * hi), sv = *(const f32x4*)(cs + (size_t)tok * 16 + 8 + 4 * hi);
#pragma unroll
                for (int e = 0; e < 4; ++e) { const float x1 = acc[e], x2 = acc[4 + e]; acc[e] = x1 * cv[e] - x2 * sv[e]; acc[4 + e] = x2 * cv[e] + x1 * sv[e]; }
            }
            bf16* dst = (n0 < 64) ? ((bf16*)(C.ws + WS_KB) + (size_t)tok * 64 + n0) : ((bf16*)(C.ws + WS_VB) + (size_t)tok * 512 + (n0 - 64));
#pragma unroll
            for (int g = 0; g < 4; ++g) { u32x2 w; w.x = cvtpk(acc[4 * g], acc[4 * g + 1]); w.y = cvtpk(acc[4 * g + 2], acc[4 * g + 3]); *(u32x2*)(dst + 8 * g + 4 * hi) = w; }
        }
    }
}

__device__ __forceinline__ void p7_final_norm(const Ctx& C) {
    for (int m = C.gw; m < M; m += C.NGW) {
        GAS f32x4* xr = (GAS f32x4*)(C.out + (size_t)m * DM) + C.lane;
        const GAS f32x4* gr = (const GAS f32x4*)C.g_fin + C.lane;
        f32x4 v[4]; float s = 0.f;
#pragma unroll
        for (int j = 0; j < 4; ++j) { v[j] = xr[64 * j]; s += (v[j].x * v[j].x + v[j].y * v[j].y) + (v[j].z * v[j].z + v[j].w * v[j].w); }
        const float rs = 1.0f / sqrtf(wave_sum(s) * (1.0f / DM) + EPS);
#pragma unroll
        for (int j = 0; j < 4; ++j) xr[64 * j] = v[j] * rs * gr[64 * j];
    }
}

#ifndef P5_MFMA
#define P5_MFMA 1
#endif
#ifndef P2_MFMA
#define P2_MFMA 1
#endif
#ifndef P3_MFMA
#define P3_MFMA 1
#endif
#ifndef P4_MFMA
#define P4_MFMA 1
#endif
struct Args { const void* in[12]; float* out; unsigned char* ws; int ph_lo, ph_hi, li, pad; };
__global__ void __launch_bounds__(NWAVES * 64, 2) mk_fwd(Args args) {
    extern __shared__ __attribute__((aligned(16))) unsigned char lds_raw[];
    LAS unsigned char* lds = (LAS unsigned char*)lds_raw;
    Ctx C;
    C.x = (const float*)args.in[0]; C.pos = (const int*)args.in[1]; C.g_in = (const float*)args.in[2]; C.w_in = (const float*)args.in[3]; C.g_kv = (const float*)args.in[4];
    C.w_uk = (const float*)args.in[5]; C.w_uv = (const float*)args.in[6]; C.g_ik = (const float*)args.in[7]; C.g_a = (const float*)args.in[8]; C.g_b = (const float*)args.in[9];
    C.w_out = (const float*)args.in[10]; C.g_fin = (const float*)args.in[11]; C.out = args.out; C.ws = args.ws;
    C.tid = threadIdx.x; C.lane = C.tid & 63; C.wave = __builtin_amdgcn_readfirstlane(C.tid >> 6); C.G = gridDim.x;
    C.gw = blockIdx.x * NWAVES + C.wave; C.NGW = C.G * NWAVES;
    volatile LAS unsigned* LCTL = (volatile LAS unsigned*)(lds + LDSCTL_OFF);
    if (C.tid < 64) LCTL[C.tid] = 0u;
    __syncthreads();
    gu32* ctl = (gu32*)(args.ws + WS_CTL);
    XcdBarrier bar; bar.bar = (unsigned*)(ctl + CW_BAR); bar.x = 0; bar.st = nullptr;
    if (N_LAUNCHES == 1) bar = xcd_barrier_post((unsigned*)(ctl + CW_BAR), LCTL);
    const int lo = args.ph_lo, hi = args.ph_hi;
#define IN(k) (lo <= (k) && (k) < hi)
#define SEAM(k) do { if (IN(k) && IN((k) + 1)) xcd_barrier(bar); } while (0)

    if (IN(0)) { for (int rep = 0; rep < (REPEAT_PHASE == 0 ? 2 : 1); ++rep) p0_prologue(C, lds); SEAM(0); }
    if (IN(1)) { for (int rep = 0; rep < (REPEAT_PHASE == 1 ? 2 : 1); ++rep) {
        pg8::Gemm g{(const pg8::bf16_t*)(C.ws + WS_XN), (const pg8::bf16_t*)(C.ws + WS_WIN), M, NPROJ, DM}; pg8::StaticOrder S; S.init(M, NPROJ, C.G, (int)blockIdx.x);
        pg8::EpiProj E{C.ws, (const float*)(C.ws + WS_CS)};
        pg8::gemm_phase<pg8::EpiProj, pg8::StaticOrder, true, true>(lds, g, S, E); }
        SEAM(1);
    }
    if (IN(2)) { for (int rep = 0; rep < (REPEAT_PHASE == 2 ? 2 : 1); ++rep) { if (P2_MFMA) p2_token_local_mfma(C); else p2_token_local(C, lds); } SEAM(2); }
    if (IN(3)) { for (int rep = 0; rep < (REPEAT_PHASE == 3 ? 2 : 1); ++rep) { if (P3_MFMA) p3_indexer_mfma(C, lds); else p3_indexer(C, lds); } }
    if (IN(4)) { for (int rep = 0; rep < (REPEAT_PHASE == 4 ? 2 : 1); ++rep) { if (P4_MFMA) p4_mixer_a_mfma(C, lds); else p4_mixer_a(C); } SEAM(4); }
    if (IN(5)) { for (int rep = 0; rep < (REPEAT_PHASE == 5 ? 2 : 1); ++rep) { if (P5_MFMA) p5_mixer_b_mfma(C, lds); else p5_mixer_b(C, lds); } SEAM(5); }
    if (IN(6)) { for (int rep = 0; rep < (REPEAT_PHASE == 6 ? 2 : 1); ++rep) {
        pg8::Gemm g{(const pg8::bf16_t*)(C.ws + WS_Y), (const pg8::bf16_t*)(C.ws + WS_WOUT), M, DM, DM}; pg8::StaticOrder S; S.init(M, DM, C.G, (int)blockIdx.x);
        pg8::EpiOut E{C.x, C.out, (const float*)(C.ws + WS_SSA)};
        pg8::gemm_phase<pg8::EpiOut, pg8::StaticOrder, true, true>(lds, g, S, E); }
        SEAM(6);
    }
    if (IN(7)) { p7_final_norm(C); }
#undef IN
#undef SEAM
}

extern "C" void kernel_launch(void* const* d_in, const int* in_sizes, int n_in, void* d_out, int out_size, void* d_ws, size_t ws_size, hipStream_t stream) {
    static int grid = 0;
    if (grid == 0) {
        if (n_in != 12 || in_sizes[0] != M * DM || out_size != M * DM || ws_size < WS_END) { fprintf(stderr, "kernel_launch: unexpected shapes (n_in %d, in0 %d, out %d, ws %zu)\n", n_in, n_in > 0 ? in_sizes[0] : -1, out_size, ws_size); grid = -1; return; }
        int dev = 0, cus = 0, per_cu = 0;
        if (hipGetDevice(&dev) != hipSuccess || hipDeviceGetAttribute(&cus, hipDeviceAttributeMultiprocessorCount, dev) != hipSuccess) { grid = -1; return; }
        if (hipFuncSetAttribute((const void*)mk_fwd, hipFuncAttributeMaxDynamicSharedMemorySize, LDS_BYTES) != hipSuccess) { fprintf(stderr, "kernel_launch: hipFuncSetAttribute failed\n"); grid = -1; return; }
        if (hipOccupancyMaxActiveBlocksPerMultiprocessor(&per_cu, (const void*)mk_fwd, NWAVES * 64, LDS_BYTES) != hipSuccess || per_cu < 1) fprintf(stderr, "kernel_launch: occupancy query reports %d\n", per_cu);
        (void)hipGetLastError();
        grid = cus;
    }
    if (grid < 0) return;
    if (hipMemsetAsync((char*)d_ws + WS_CTL, 0, CTL_ZERO_BYTES, stream) != hipSuccess) return;
    Args a{};
    for (int i = 0; i < 12; ++i) a.in[i] = d_in[i];
    a.out = (float*)d_out; a.ws = (unsigned char*)d_ws;
    for (int li = 0; li < N_LAUNCHES; ++li) {
        a.ph_lo = (N_LAUNCHES == 1) ? 0 : li; a.ph_hi = (N_LAUNCHES == 1) ? N_PHASES : li + 1; a.li = li;
        hipLaunchKernelGGL(mk_fwd, dim3(grid), dim3(NWAVES * 64), LDS_BYTES, stream, a);
        const hipError_t le = hipPeekAtLastError();
        if (le != hipSuccess) { fprintf(stderr, "kernel_launch: launch %d failed: %s\n", li, hipGetErrorName(le)); break; }
    }
}
```
